# Optimizing an MI355X kernel written in HIP

```python
import jax
import jax.numpy as jnp
from jax import lax
import numpy as np

D_MODEL = 1024
BATCH = 8
SEQ = 2048
DEPTH = 2

GRID_W = 64
CTX_LEN = 256
EPS = 1e-6
ROPE_BASE = 10000.0

GLA_HEADS = 4
GLA_DK = 128
GLA_DV = 256
GLA_GATE_RANK = 16
GLA_GATE_NORM = 16.0
GLA_CHUNK = 64
SWA_HEADS = 16
SWA_KV_HEADS = 2
SWA_GROUP = SWA_HEADS // SWA_KV_HEADS
SWA_HEAD_DIM = 64
WINDOW = 128
SWA_BLOCK = 128
MLA_HEADS = 8
MLA_Q_RANK = 384
MLA_KV_RANK = 256
MLA_NOPE = 128
MLA_ROPE = 64
MLA_V = 128
MLA_BLOCK = 128
D_FF = -(-(8 * D_MODEL) // (3 * 256)) * 256

IN_SPLITS = (
    GLA_HEADS * GLA_DK, GLA_HEADS * GLA_DK, GLA_HEADS * GLA_DV, GLA_HEADS * GLA_DV,
    GLA_GATE_RANK, GLA_GATE_RANK,
    SWA_HEADS * SWA_HEAD_DIM, SWA_KV_HEADS * SWA_HEAD_DIM, SWA_KV_HEADS * SWA_HEAD_DIM,
    MLA_Q_RANK, MLA_KV_RANK, MLA_ROPE,
    3 * D_MODEL,
)
D_IN = sum(IN_SPLITS)

kernel_name = 'hybrid_gla_swa_mla_dit_trunk'


def rmsnorm(x, g):
    x32 = x.astype(jnp.float32)
    y = x32 * lax.rsqrt(jnp.mean(x32 * x32, axis=-1, keepdims=True) + EPS)
    return (y * g.astype(jnp.float32)).astype(x.dtype)


def modulate(x, shift, scale):
    return x * (1 + scale) + shift


def split_cols(z):
    out, idx = [], 0
    for n in IN_SPLITS:
        out.append(z[..., idx:idx + n])
        idx += n
    return out


def to_heads(z, n):
    b_, t_, _ = z.shape
    return z.reshape(b_, t_, n, -1).transpose(0, 2, 1, 3)


def from_heads(z):
    b_, n, t_, d = z.shape
    return z.transpose(0, 2, 1, 3).reshape(b_, t_, n * d)


def grid_positions(n_tokens):
    rows = n_tokens // GRID_W
    row = jnp.broadcast_to(jnp.arange(rows, dtype=jnp.int32)[:, None], (rows, GRID_W)).reshape(-1)
    col = jnp.broadcast_to(jnp.arange(GRID_W, dtype=jnp.int32)[None, :], (rows, GRID_W)).reshape(-1)
    return row, col


def rope_1d(x, pos):
    half = x.shape[-1] // 2
    inv = jnp.power(ROPE_BASE, -jnp.arange(half, dtype=jnp.float32) / half)
    ang = pos.astype(jnp.float32)[:, None] * inv[None, :]
    cos, sin = jnp.cos(ang), jnp.sin(ang)
    x1 = x[..., :half].astype(jnp.float32)
    x2 = x[..., half:].astype(jnp.float32)
    return jnp.concatenate([x1 * cos - x2 * sin, x2 * cos + x1 * sin], axis=-1).astype(x.dtype)


def rope_2d(x, row, col):
    h = x.shape[-1] // 2
    return jnp.concatenate([rope_1d(x[..., :h], row), rope_1d(x[..., h:], col)], axis=-1)


def gla_chunked(q, k, v, log_a, s0, strict):
    b_, h_, t_, _ = q.shape
    dv = v.shape[-1]
    n = t_ // GLA_CHUNK
    ch = lambda z: z.astype(jnp.float32).reshape(b_, h_, n, GLA_CHUNK, z.shape[-1])
    q, k, v, log_a = ch(q), ch(k), ch(v), ch(log_a)
    cum = jnp.cumsum(log_a, axis=3)
    last = cum[:, :, :, -1:, :]
    q_dec = q * jnp.exp(cum)
    k_inv = k * jnp.exp(-cum)
    k_end = k * jnp.exp(last - cum)
    mask = jnp.tril(jnp.ones((GLA_CHUNK, GLA_CHUNK), dtype=bool), k=-1 if strict else 0)
    scores = jnp.where(mask, jnp.einsum('bhncd,bhnsd->bhncs', q_dec, k_inv), 0.0)
    o_intra = jnp.einsum('bhncs,bhnsv->bhncv', scores, v)
    kv_add = jnp.einsum('bhnsd,bhnsv->bhndv', k_end, v)
    decay = jnp.exp(last[:, :, :, 0, :])

    def step(state, xs):
        q_c, kv_c, dec_c = xs
        o_c = jnp.einsum('bhcd,bhdv->bhcv', q_c, state)
        return dec_c[..., None] * state + kv_c, o_c

    xs = (jnp.moveaxis(q_dec, 2, 0), jnp.moveaxis(kv_add, 2, 0), jnp.moveaxis(decay, 2, 0))
    s_fin, o_inter = lax.scan(step, s0.astype(jnp.float32), xs)
    o = o_intra + jnp.moveaxis(o_inter, 0, 2)
    return o.reshape(b_, h_, t_, dv), s_fin


def gla_bidir(q, k, v, la_f, la_b, s0_f, s0_b):
    flip = lambda z: jnp.flip(z, axis=2)
    o_f, s_f = gla_chunked(q, k, v, la_f, s0_f, strict=False)
    o_b, s_b = gla_chunked(flip(q), flip(k), flip(v), flip(la_b), s0_b, strict=True)
    return o_f + flip(o_b), s_f, s_b


def sink_attend(q, k, v, mask, sink):
    scale = q.shape[-1] ** -0.5
    s = jnp.einsum('bgrqd,bgkd->bgrqk', q, k, preferred_element_type=jnp.float32) * scale
    s = jnp.where(mask, s, -jnp.inf)
    sk = sink.astype(jnp.float32)[None, :, :, None, None]
    m = jnp.maximum(jnp.max(s, axis=-1, keepdims=True), sk)
    p = jnp.exp(s - m)
    den = jnp.sum(p, axis=-1, keepdims=True) + jnp.exp(sk - m)
    o = jnp.einsum('bgrqk,bgkd->bgrqd', p, v.astype(jnp.float32)) / den
    return o.astype(q.dtype)


def swa_latent(q, k, v, kc, vc, sink):
    b_, g_, r_, t_, d = q.shape
    nb = t_ // SWA_BLOCK
    span = 3 * SWA_BLOCK
    pad = ((0, 0), (0, 0), (SWA_BLOCK, SWA_BLOCK), (0, 0))
    kp, vp = jnp.pad(k, pad), jnp.pad(v, pad)
    off = jnp.arange(span) - SWA_BLOCK
    rel = off[None, :] - jnp.arange(SWA_BLOCK)[:, None]
    ctx_ok = jnp.ones((SWA_BLOCK, kc.shape[2]), dtype=bool)
    q_blocks = jnp.moveaxis(q.reshape(b_, g_, r_, nb, SWA_BLOCK, d), 3, 0)

    def one_block(args):
        i, q_i = args
        start = i * SWA_BLOCK
        k_i = jnp.concatenate([lax.dynamic_slice_in_dim(kp, start, span, axis=2), kc], axis=2)
        v_i = jnp.concatenate([lax.dynamic_slice_in_dim(vp, start, span, axis=2), vc], axis=2)
        key_pos = start + off
        band = (jnp.abs(rel) <= WINDOW) & ((key_pos >= 0) & (key_pos < t_))[None, :]
        return sink_attend(q_i, k_i, v_i, jnp.concatenate([band, ctx_ok], axis=1), sink)

    o = lax.map(one_block, (jnp.arange(nb), q_blocks))
    return jnp.moveaxis(o, 0, 3).reshape(b_, g_, r_, t_, d)


def mla_attend(qn, qr, kn, kr, v):
    b_, h_, t_, _ = qn.shape
    nb = t_ // MLA_BLOCK
    scale = (MLA_NOPE + MLA_ROPE) ** -0.5
    blocks = lambda z: jnp.moveaxis(z.reshape(b_, h_, nb, MLA_BLOCK, z.shape[-1]), 2, 0)

    def one_block(args):
        qn_i, qr_i = args
        s = jnp.einsum('bhqd,bhkd->bhqk', qn_i, kn, preferred_element_type=jnp.float32)
        s = s + jnp.einsum('bhqd,bkd->bhqk', qr_i, kr, preferred_element_type=jnp.float32)
        p = jax.nn.softmax(s * scale, axis=-1)
        return jnp.einsum('bhqk,bhkd->bhqd', p.astype(v.dtype), v)

    o = lax.map(one_block, (blocks(qn), blocks(qr)))
    return jnp.moveaxis(o, 0, 2).reshape(b_, h_, t_, v.shape[-1])


def token_mixer(h, hc, row, col, with_ctx_out, w_in, w_gk_fwd, b_gk_fwd, w_gk_bwd, b_gk_bwd,
                gla_norm, sinks, q_norm, w_q_up, kv_norm, w_kv_up, w_pa, w_pb, w_pc, w_o):
    (qa, ka, va, ga, gkf, gkb, qs, ks, vs, cq, ckv, kr, mg) = split_cols(h @ w_in)
    (qa_c, ka_c, va_c, ga_c, gkf_c, gkb_c, qs_c, ks_c, vs_c, cq_c, ckv_c, kr_c, mg_c) = split_cols(hc @ w_in)

    def gla_prep(q, k, v, gf, gb):
        la_f = jax.nn.log_sigmoid(gf @ w_gk_fwd + b_gk_fwd) / GLA_GATE_NORM
        la_b = jax.nn.log_sigmoid(gb @ w_gk_bwd + b_gk_bwd) / GLA_GATE_NORM
        return (to_heads(q, GLA_HEADS) * GLA_DK ** -0.5, to_heads(k, GLA_HEADS), to_heads(v, GLA_HEADS),
                to_heads(la_f, GLA_HEADS), to_heads(la_b, GLA_HEADS))

    def gla_post(o, g):
        return from_heads(rmsnorm(o, gla_norm)).astype(g.dtype) * jax.nn.silu(g)

    zero = jnp.zeros((hc.shape[0], GLA_HEADS, GLA_DK, GLA_DV), jnp.float32)
    o_a_c, s_f, s_b = gla_bidir(*gla_prep(qa_c, ka_c, va_c, gkf_c, gkb_c), zero, zero)
    o_a, _, _ = gla_bidir(*gla_prep(qa, ka, va, gkf, gkb), s_f, s_b)

    def swa_prep(q, k, v, rotate):
        q, k, v = to_heads(q, SWA_HEADS), to_heads(k, SWA_KV_HEADS), to_heads(v, SWA_KV_HEADS)
        if rotate:
            q, k = rope_2d(q, row, col), rope_2d(k, row, col)
        b_, _, t_, d = q.shape
        return q.reshape(b_, SWA_KV_HEADS, SWA_GROUP, t_, d), k, v

    def swa_post(o):
        b_, g_, r_, t_, d = o.shape
        return from_heads(o.reshape(b_, g_ * r_, t_, d))

    sink = sinks.reshape(SWA_KV_HEADS, SWA_GROUP)
    q_b, k_b, v_b = swa_prep(qs, ks, vs, True)
    q_bc, k_bc, v_bc = swa_prep(qs_c, ks_c, vs_c, False)
    o_b = swa_latent(q_b, k_b, v_b, k_bc, v_bc, sink)

    def mla_prep(cq_, ckv_, kr_, rotate):
        qf = to_heads(rmsnorm(cq_, q_norm) @ w_q_up, MLA_HEADS)
        kvf = to_heads(rmsnorm(ckv_, kv_norm) @ w_kv_up, MLA_HEADS)
        qn_, qr_ = qf[..., :MLA_NOPE], qf[..., MLA_NOPE:]
        kn_, v_ = kvf[..., :MLA_NOPE], kvf[..., MLA_NOPE:]
        if rotate:
            qr_, kr_ = rope_2d(qr_, row, col), rope_2d(kr_, row, col)
        return qn_, qr_, kn_, kr_, v_

    qn, qr, kn, kro, vm = mla_prep(cq, ckv, kr, True)
    qn_c, qr_c, kn_c, kro_c, vm_c = mla_prep(cq_c, ckv_c, kr_c, False)
    o_c = mla_attend(qn, qr, jnp.concatenate([kn, kn_c], axis=2), jnp.concatenate([kro, kro_c], axis=1),
                     jnp.concatenate([vm, vm_c], axis=2))

    def merge(y_a, y_b, y_c, gates):
        g_a, g_b, g_c = jnp.split(jax.nn.sigmoid(gates), 3, axis=-1)
        return (g_a * (y_a @ w_pa) + g_b * (y_b @ w_pb) + g_c * (y_c @ w_pc)) @ w_o

    y = merge(gla_post(o_a, ga), swa_post(o_b), from_heads(o_c), mg)
    if not with_ctx_out:
        return y, None
    l_c = hc.shape[1]
    o_b_c = sink_attend(q_bc, k_bc, v_bc, jnp.ones((l_c, l_c), dtype=bool), sink)
    o_c_c = mla_attend(qn_c, qr_c, kn_c, kro_c, vm_c)
    y_ctx = merge(gla_post(o_a_c, ga_c), swa_post(o_b_c), from_heads(o_c_c), mg_c)
    return y, y_ctx


def swiglu(h, w_in, w_out):
    gate, up = jnp.split(h @ w_in, 2, axis=-1)
    return (jax.nn.silu(gate) * up) @ w_out


def setup_inputs(seed: int = 0) -> dict:
    key = jax.random.key(seed)
    keys = iter(jax.random.split(key, 32))
    f32 = jnp.float32

    def w(shape, fan_in, gain=1.0):
        return jax.random.normal(next(keys), shape, f32) * (gain * fan_in ** -0.5)

    def norm_gain(shape):
        return 1.0 + 0.02 * jax.random.normal(next(keys), shape, f32)

    def small(shape, s):
        return s * jax.random.normal(next(keys), shape, f32)

    L = DEPTH
    return {
        'x': jax.random.normal(next(keys), (BATCH, SEQ, D_MODEL), f32),
        'c': jax.random.normal(next(keys), (BATCH, D_MODEL), f32),
        'ctx': jax.random.normal(next(keys), (BATCH, CTX_LEN, D_MODEL), f32),
        'c_ctx': jax.random.normal(next(keys), (D_MODEL,), f32),
        'w_mod': w((L, D_MODEL, 6 * D_MODEL), D_MODEL, 0.5),
        'b_mod': small((L, 6 * D_MODEL), 0.02),
        'norm_mix': norm_gain((L, D_MODEL)),
        'w_in': w((L, D_MODEL, D_IN), D_MODEL),
        'w_gk_fwd': w((L, GLA_GATE_RANK, GLA_HEADS * GLA_DK), GLA_GATE_RANK),
        'b_gk_fwd': small((L, GLA_HEADS * GLA_DK), 0.1),
        'w_gk_bwd': w((L, GLA_GATE_RANK, GLA_HEADS * GLA_DK), GLA_GATE_RANK),
        'b_gk_bwd': small((L, GLA_HEADS * GLA_DK), 0.1),
        'gla_norm': norm_gain((L, GLA_DV)),
        'sinks': small((L, SWA_HEADS), 0.5),
        'q_norm': norm_gain((L, MLA_Q_RANK)),
        'w_q_up': w((L, MLA_Q_RANK, MLA_HEADS * (MLA_NOPE + MLA_ROPE)), MLA_Q_RANK),
        'kv_norm': norm_gain((L, MLA_KV_RANK)),
        'w_kv_up': w((L, MLA_KV_RANK, MLA_HEADS * (MLA_NOPE + MLA_V)), MLA_KV_RANK),
        'w_pa': w((L, GLA_HEADS * GLA_DV, D_MODEL), GLA_HEADS * GLA_DV),
        'w_pb': w((L, SWA_HEADS * SWA_HEAD_DIM, D_MODEL), SWA_HEADS * SWA_HEAD_DIM),
        'w_pc': w((L, MLA_HEADS * MLA_V, D_MODEL), MLA_HEADS * MLA_V),
        'w_o': w((L, D_MODEL, D_MODEL), D_MODEL),
        'norm_ffn': norm_gain((L, D_MODEL)),
        'w_ffn_in': w((L, D_MODEL, 2 * D_FF), D_MODEL),
        'w_ffn_out': w((L, D_FF, D_MODEL), D_FF),
        'final_norm': norm_gain((D_MODEL,)),
    }


def reference(x, c, ctx, c_ctx, w_mod, b_mod, norm_mix, w_in, w_gk_fwd, b_gk_fwd, w_gk_bwd, b_gk_bwd,
              gla_norm, sinks, q_norm, w_q_up, kv_norm, w_kv_up, w_pa, w_pb, w_pc, w_o,
              norm_ffn, w_ffn_in, w_ffn_out, final_norm):
    row, col = grid_positions(x.shape[1])
    xc = ctx
    for l in range(DEPTH):
        last = l == DEPTH - 1
        mod = jax.nn.silu(c) @ w_mod[l] + b_mod[l]
        mod_c = jax.nn.silu(c_ctx) @ w_mod[l] + b_mod[l]
        sh1, sc1, g1, sh2, sc2, g2 = [m[:, None, :] for m in jnp.split(mod, 6, axis=-1)]
        sh1c, sc1c, g1c, sh2c, sc2c, g2c = jnp.split(mod_c, 6, axis=-1)
        h = modulate(rmsnorm(x, norm_mix[l]), sh1, sc1)
        hc = modulate(rmsnorm(xc, norm_mix[l]), sh1c, sc1c)
        y, y_ctx = token_mixer(h, hc, row, col, not last, w_in[l], w_gk_fwd[l], b_gk_fwd[l],
                               w_gk_bwd[l], b_gk_bwd[l], gla_norm[l], sinks[l], q_norm[l], w_q_up[l],
                               kv_norm[l], w_kv_up[l], w_pa[l], w_pb[l], w_pc[l], w_o[l])
        x = x + g1 * y
        x = x + g2 * swiglu(modulate(rmsnorm(x, norm_ffn[l]), sh2, sc2), w_ffn_in[l], w_ffn_out[l])
        if not last:
            xc = xc + g1c * y_ctx
            xc = xc + g2c * swiglu(modulate(rmsnorm(xc, norm_ffn[l]), sh2c, sc2c), w_ffn_in[l], w_ffn_out[l])
    return rmsnorm(x, final_norm)
```

```cpp
#include <hip/hip_runtime.h>
#include <hip/hip_cooperative_groups.h>
#include <cstdio>
#include <cstdint>
namespace cg = cooperative_groups;
#define DI __device__ __forceinline__
typedef unsigned short bf16_t;
typedef short bf16x8 __attribute__((ext_vector_type(8)));
typedef short s16x4 __attribute__((ext_vector_type(4)));
typedef float f32x4 __attribute__((ext_vector_type(4)));
typedef unsigned u32x2 __attribute__((ext_vector_type(2)));
typedef unsigned u32x4 __attribute__((ext_vector_type(4)));

constexpr int TT = 2304;
constexpr int BG = 4;
constexpr int NGRP = 2;
constexpr int R = BG * TT;
constexpr int RALL = 8 * TT;
constexpr float LOG2E = 1.4426950408889634f;

constexpr size_t OFF_CTR = 0;
constexpr size_t OFF_MOD = 4096;
constexpr size_t OFF_ROPE = OFF_MOD + 2 * 9 * 6144 * 4;
constexpr size_t OFF_RSQ = OFF_ROPE + 64 * 16 * 8;
constexpr size_t OFF_XBAR = OFF_RSQ + (size_t)2 * R * 4;
constexpr size_t OFF_XC = OFF_XBAR + 16384;
constexpr size_t OFF_WM = OFF_XC + (size_t)2048 * 1024 * 4;
constexpr size_t WM_WIN = 0;
constexpr size_t WM_WQU = WM_WIN + (size_t)8192 * 1024 * 2;
constexpr size_t WM_WKVU = WM_WQU + (size_t)1536 * 384 * 2;
constexpr size_t WM_WPA = WM_WKVU + (size_t)2048 * 256 * 2;
constexpr size_t WM_WPB = WM_WPA + (size_t)1024 * 1024 * 2;
constexpr size_t WM_WPC = WM_WPB + (size_t)1024 * 1024 * 2;
constexpr size_t WM_WO = WM_WPC + (size_t)1024 * 1024 * 2;
constexpr size_t WM_SIZE = WM_WO + (size_t)1024 * 1024 * 2;
constexpr size_t OFF_ACT = OFF_WM + WM_SIZE;
constexpr size_t A_H = 0;
constexpr size_t A_GQK = A_H + (size_t)R * 2048;
constexpr size_t A_GVT = A_GQK + (size_t)R * 2048;
constexpr size_t A_GG = A_GVT + (size_t)R * 2048;
constexpr size_t A_GKR = A_GG + (size_t)R * 2048;
constexpr size_t A_SQ = A_GKR + (size_t)R * 128;
constexpr size_t A_SK = A_SQ + (size_t)R * 2048;
constexpr size_t A_SVT = A_SK + (size_t)R * 256;
constexpr size_t A_CQ = A_SVT + (size_t)R * 256;
constexpr size_t A_CKV = A_CQ + (size_t)R * 768;
constexpr size_t A_KR = A_CKV + (size_t)R * 512;
constexpr size_t A_QF = A_KR + (size_t)R * 128;
constexpr size_t A_KN = A_QF + (size_t)R * 3072;
constexpr size_t A_VT = A_KN + (size_t)R * 2048;
constexpr size_t A_MG = A_VT + (size_t)R * 2048;
constexpr size_t A_OB = A_MG + (size_t)R * 6144;
constexpr size_t ACT_SIZE = A_OB + (size_t)R * 2048;
constexpr size_t F_H2 = 0;
constexpr size_t F_HID = F_H2 + (size_t)RALL * 2048;
constexpr size_t F_WFI = F_HID + (size_t)RALL * 5632;
constexpr size_t F_WFO = F_WFI + (size_t)5632 * 1024 * 2;
constexpr size_t WS_NEED = OFF_ACT + ACT_SIZE;

constexpr int LDS_BYTES = 151552;
constexpr int G_BUF = 49152, G_BOFF = 32768, G_EXTRA = 147456;
constexpr int L_QD = 0, L_KI = L_QD + 17408, L_KET = L_KI + 17408, L_VT = L_KET + 18432, L_ST = L_VT + 9216,
              L_WG = L_ST + 17408, L_BG = L_WG + 8192, L_ETOT = L_BG + 512, L_END = L_ETOT + 512;
constexpr int L_ITEM = LDS_BYTES - 16;
static_assert(L_END <= L_ITEM, "lds");

struct Params {
  const float *x, *c, *ctx, *c_ctx, *w_mod, *b_mod, *norm_mix, *w_in, *w_gk_fwd, *b_gk_fwd, *w_gk_bwd, *b_gk_bwd, *gla_norm, *sinks,
      *q_norm, *w_q_up, *kv_norm, *w_kv_up, *w_pa, *w_pb, *w_pc, *w_o, *norm_ffn, *w_ffn_in, *w_ffn_out, *final_norm;
  float* out;
  unsigned char* ws;
};

extern __shared__ __attribute__((aligned(16))) unsigned char dyn_lds[];

typedef __bf16 bf16x2_t __attribute__((ext_vector_type(2)));
typedef float f32x2_t __attribute__((ext_vector_type(2)));
DI unsigned pk2(float lo, float hi) { f32x2_t f = {lo, hi}; bf16x2_t v = __builtin_convertvector(f, bf16x2_t); return __builtin_bit_cast(unsigned, v); }
DI float bflo(unsigned w) { return __uint_as_float(w << 16); }
DI float bfhi(unsigned w) { return __uint_as_float(w & 0xffff0000u); }
DI float bf2f(bf16_t v) { return __uint_as_float(((unsigned)v) << 16); }
DI bf16_t f2bf(float x) { return (bf16_t)(pk2(x, 0.f) & 0xffffu); }
DI u32x2 pk4(f32x4 v) { u32x2 r; r.x = pk2(v[0], v[1]); r.y = pk2(v[2], v[3]); return r; }
DI float sigmoidf_(float x) { return __builtin_amdgcn_rcpf(1.0f + __builtin_amdgcn_exp2f(-1.4426950408889634f * x)); }
DI float siluf_(float x) { return x * __builtin_amdgcn_rcpf(1.0f + __builtin_amdgcn_exp2f(-1.4426950408889634f * x)); }
DI int opaque_tid() { int t = threadIdx.x; asm volatile("" : "+v"(t)); return t; }

template <int CTRL, int ROWMASK, bool BOUND>
DI float dpp_move(float x) { return __builtin_bit_cast(float, __builtin_amdgcn_update_dpp(0, __builtin_bit_cast(int, x), CTRL, ROWMASK, 0xF, BOUND)); }
DI float wave_incl_scan(float x) {
  x += dpp_move<0x111, 0xF, true>(x);
  x += dpp_move<0x112, 0xF, true>(x);
  x += dpp_move<0x114, 0xF, true>(x);
  x += dpp_move<0x118, 0xF, true>(x);
  x += dpp_move<0x142, 0xA, false>(x);
  x += dpp_move<0x143, 0xC, false>(x);
  return x;
}
DI float shx(float v, int lane, int m) { return __builtin_bit_cast(float, __builtin_amdgcn_ds_bpermute((lane ^ m) << 2, __builtin_bit_cast(int, v))); }
#define LDS_BARRIER() do { asm volatile("s_waitcnt lgkmcnt(0)" ::: "memory"); __builtin_amdgcn_s_barrier(); asm volatile("" ::: "memory"); } while (0)
#define MFMA16(a, b, c) __builtin_amdgcn_mfma_f32_16x16x32_bf16((a), (b), (c), 0, 0, 0)

#define LAS __attribute__((address_space(3)))
template <bool SWAP, bool ASEG, bool DEEP = true>
DI void gemm_tile(const bf16_t* __restrict__ A, int lda, const bf16_t* __restrict__ Bt, int ldb, int K, unsigned char* lds,
                  f32x4 (&acc)[4][4]) {
  const int tid = opaque_tid(), lane = tid & 63, w = tid >> 6, wm = w >> 1, wn = w & 1, l15 = lane & 15, quad = lane >> 4;
  const int lrow = tid >> 3;
  const int lchs = (tid & 7) ^ ((lrow >> 1) & 7);
  const int nk = K >> 6;
  const unsigned voffA = (unsigned)(lrow * lda + lchs * 8) * 2u, voffB = (unsigned)(lrow * ldb + lchs * 8) * 2u;
  const char* Ab = (const char*)A; const char* Bb = (const char*)Bt;
  LAS unsigned char* l3 = (LAS unsigned char*)dyn_lds;
  const int sw0 = ((quad ^ (l15 >> 1)) * 16), sw1 = (((4 + quad) ^ (l15 >> 1)) * 16);
  const int arow = (wm * 64 + l15) * 128, brow = G_BOFF + (wn * 64 + l15) * 128;
#define GT_DMA(KT, ST) do { const int ku_ = ASEG ? (((KT) >> 1) * 192 + ((KT) & 1) * 64) : (KT) * 64; \
    _Pragma("unroll") for (int i = 0; i < 4; ++i) __builtin_amdgcn_global_load_lds((const unsigned*)(Ab + (size_t)(64 * i * lda + ku_) * 2 + voffA), \
        (LAS unsigned*)(l3 + (ST) * G_BUF + i * 8192 + w * 1024), 16, 0, 0); \
    _Pragma("unroll") for (int i = 0; i < 2; ++i) __builtin_amdgcn_global_load_lds((const unsigned*)(Bb + (size_t)(64 * i * ldb + (KT) * 64) * 2 + voffB), \
        (LAS unsigned*)(l3 + (ST) * G_BUF + G_BOFF + i * 8192 + w * 1024), 16, 0, 0); } while (0)
#define GT_READ(AF, BF, ST, KS) do { const unsigned char* base_ = lds + (ST) * G_BUF + ((KS) ? sw1 : sw0); \
    _Pragma("unroll") for (int mt = 0; mt < 4; ++mt) AF[mt] = *(const bf16x8*)(base_ + arow + mt * 16 * 128); \
    _Pragma("unroll") for (int nt = 0; nt < 4; ++nt) BF[nt] = *(const bf16x8*)(base_ + brow + nt * 16 * 128); } while (0)
#define GT_MMA(AF, BF) do { _Pragma("unroll") for (int mt = 0; mt < 4; ++mt) _Pragma("unroll") for (int nt = 0; nt < 4; ++nt) \
      acc[mt][nt] = SWAP ? MFMA16(BF[nt], AF[mt], acc[mt][nt]) : MFMA16(AF[mt], BF[nt], acc[mt][nt]); } while (0)
  bf16x8 fa0[4], fb0[4], fa1[4], fb1[4];
  GT_DMA(0, 0);
  GT_DMA(1, 1);
  asm volatile("s_waitcnt vmcnt(6)" ::: "memory");
  LDS_BARRIER();
  int st = 0;
  for (int kt = 0; kt < nk; ++kt) {
    const bool more2 = (kt + 2 < nk);
    if (more2) { const int s2 = st == 0 ? 2 : st - 1; GT_DMA(kt + 2, s2); }
    GT_READ(fa0, fb0, st, 0);
    GT_READ(fa1, fb1, st, 1);
    GT_MMA(fa0, fb0);
    GT_MMA(fa1, fb1);
    if (more2) asm volatile("s_waitcnt vmcnt(6)" ::: "memory"); else asm volatile("s_waitcnt vmcnt(0)" ::: "memory");
    LDS_BARRIER();
    st = st == 2 ? 0 : st + 1;
  }
#undef GT_DMA
#undef GT_READ
#undef GT_MMA
}
template <bool ASEG>
DI void gemm_tile_n64(const bf16_t* __restrict__ A, int lda, const bf16_t* __restrict__ Bt, int ldb, int K, unsigned char* lds,
                      f32x4 (&acc)[4][2]) {
  const int tid = opaque_tid(), lane = tid & 63, w = tid >> 6, wm = w >> 1, wn = w & 1, l15 = lane & 15, quad = lane >> 4;
  const int lrow = tid >> 3;
  const int lchs = (tid & 7) ^ ((lrow >> 1) & 7);
  const int nk = K >> 6;
  const unsigned voffA = (unsigned)(lrow * lda + lchs * 8) * 2u, voffB = (unsigned)(lrow * ldb + lchs * 8) * 2u;
  const char* Ab = (const char*)A; const char* Bb = (const char*)Bt;
  LAS unsigned char* l3 = (LAS unsigned char*)dyn_lds;
  const int sw0 = ((quad ^ (l15 >> 1)) * 16), sw1 = (((4 + quad) ^ (l15 >> 1)) * 16);
  const int arow = (wm * 64 + l15) * 128, brow = G_BOFF + (wn * 32 + l15) * 128;
#define GN_DMA(KT, ST) do { const int ku_ = ASEG ? (((KT) >> 1) * 192 + ((KT) & 1) * 64) : (KT) * 64; \
    _Pragma("unroll") for (int i = 0; i < 4; ++i) __builtin_amdgcn_global_load_lds((const unsigned*)(Ab + (size_t)(64 * i * lda + ku_) * 2 + voffA), \
        (LAS unsigned*)(l3 + (ST) * G_BUF + i * 8192 + w * 1024), 16, 0, 0); \
    __builtin_amdgcn_global_load_lds((const unsigned*)(Bb + (size_t)((KT) * 64) * 2 + voffB), (LAS unsigned*)(l3 + (ST) * G_BUF + G_BOFF + w * 1024), 16, 0, 0); } while (0)
  GN_DMA(0, 0);
  GN_DMA(1, 1);
  asm volatile("s_waitcnt vmcnt(5)" ::: "memory");
  LDS_BARRIER();
  int st = 0;
  for (int kt = 0; kt < nk; ++kt) {
    const bool more2 = (kt + 2 < nk);
    if (more2) { const int s2 = st == 0 ? 2 : st - 1; GN_DMA(kt + 2, s2); }
#pragma unroll
    for (int ks = 0; ks < 2; ++ks) {
      const unsigned char* base_ = lds + st * G_BUF + (ks ? sw1 : sw0);
      bf16x8 fa[4], fb[2];
#pragma unroll
      for (int mt = 0; mt < 4; ++mt) fa[mt] = *(const bf16x8*)(base_ + arow + mt * 16 * 128);
#pragma unroll
      for (int nt = 0; nt < 2; ++nt) fb[nt] = *(const bf16x8*)(base_ + brow + nt * 16 * 128);
#pragma unroll
      for (int mt = 0; mt < 4; ++mt)
#pragma unroll
        for (int nt = 0; nt < 2; ++nt) acc[mt][nt] = MFMA16(fb[nt], fa[mt], acc[mt][nt]);
    }
    if (more2) asm volatile("s_waitcnt vmcnt(5)" ::: "memory"); else asm volatile("s_waitcnt vmcnt(0)" ::: "memory");
    LDS_BARRIER();
    st = st == 2 ? 0 : st + 1;
  }
#undef GN_DMA
}
DI void zero_acc(f32x4 (&acc)[4][4]) {
#pragma unroll
  for (int a = 0; a < 4; ++a)
#pragma unroll
    for (int b = 0; b < 4; ++b) acc[a][b] = (f32x4){0.f, 0.f, 0.f, 0.f};
}

template <bool SWAP>
DI void gemm_tile2(const bf16_t* __restrict__ A, int lda, const bf16_t* __restrict__ Bt, int ldb, int K, unsigned char* lds,
                   f32x4 (&acc0)[4][4], f32x4 (&acc1)[4][4]) {
  const int tid = opaque_tid(), lane = tid & 63, w = tid >> 6, wm = w >> 1, wn = w & 1, l15 = lane & 15, quad = lane >> 4;
  const int lrow = tid >> 3;
  const int lchs = (tid & 7) ^ ((lrow >> 1) & 7);
  const int nk = K >> 6;
  const unsigned voffA = (unsigned)(lrow * lda + lchs * 8) * 2u, voffB = (unsigned)(lrow * ldb + lchs * 8) * 2u;
  const char* Ab = (const char*)A; const char* Bb = (const char*)Bt;
  LAS unsigned char* l3 = (LAS unsigned char*)dyn_lds;
  const int sw0 = ((quad ^ (l15 >> 1)) * 16), sw1 = (((4 + quad) ^ (l15 >> 1)) * 16);
  const int arow = (wm * 64 + l15) * 128, brow = 32768 + (wn * 64 + l15) * 128;
  constexpr int SB = 65536;
#define G2_DMA(KT, ST) do { \
    _Pragma("unroll") for (int i = 0; i < 4; ++i) __builtin_amdgcn_global_load_lds((const unsigned*)(Ab + (size_t)(64 * i * lda + (KT) * 64) * 2 + voffA), \
        (LAS unsigned*)(l3 + (ST) * SB + i * 8192 + w * 1024), 16, 0, 0); \
    _Pragma("unroll") for (int i = 0; i < 4; ++i) __builtin_amdgcn_global_load_lds((const unsigned*)(Bb + (size_t)(64 * i * ldb + (KT) * 64) * 2 + voffB), \
        (LAS unsigned*)(l3 + (ST) * SB + 32768 + i * 8192 + w * 1024), 16, 0, 0); } while (0)
  G2_DMA(0, 0);
  asm volatile("s_waitcnt vmcnt(0)" ::: "memory");
  LDS_BARRIER();
  for (int kt = 0; kt < nk; ++kt) {
    const int st = kt & 1;
    if (kt + 1 < nk) G2_DMA(kt + 1, st ^ 1);
#pragma unroll
    for (int ks = 0; ks < 2; ++ks) {
      const unsigned char* base_ = lds + st * SB + (ks ? sw1 : sw0);
      bf16x8 fa[4], fb0[4], fb1[4];
#pragma unroll
      for (int mt = 0; mt < 4; ++mt) fa[mt] = *(const bf16x8*)(base_ + arow + mt * 16 * 128);
#pragma unroll
      for (int nt = 0; nt < 4; ++nt) fb0[nt] = *(const bf16x8*)(base_ + brow + nt * 16 * 128);
#pragma unroll
      for (int nt = 0; nt < 4; ++nt) fb1[nt] = *(const bf16x8*)(base_ + brow + 128 * 128 + nt * 16 * 128);
#pragma unroll
      for (int mt = 0; mt < 4; ++mt)
#pragma unroll
        for (int nt = 0; nt < 4; ++nt) acc0[mt][nt] = SWAP ? MFMA16(fb0[nt], fa[mt], acc0[mt][nt]) : MFMA16(fa[mt], fb0[nt], acc0[mt][nt]);
#pragma unroll
      for (int mt = 0; mt < 4; ++mt)
#pragma unroll
        for (int nt = 0; nt < 4; ++nt) acc1[mt][nt] = SWAP ? MFMA16(fb1[nt], fa[mt], acc1[mt][nt]) : MFMA16(fa[mt], fb1[nt], acc1[mt][nt]);
    }
    asm volatile("s_waitcnt vmcnt(0)" ::: "memory");
    LDS_BARRIER();
  }
#undef G2_DMA
}


DI bool unit_of(long L, int nM, int nN, int& pm, int& pn);
DI bool unit_order(int i, int nM, int nN, int& pm, int& pn) { return unit_of((long)i * gridDim.x + blockIdx.x, nM, nN, pm, pn); }
DI bool unit_of(long L, int nM, int nN, int& pm, int& pn) {
  const int nwg = nM * nN;
  if (L >= nwg) return false;
  int wgid = (int)L;
  { const int q = nwg / 8, r = nwg % 8, xcd = wgid % 8, off = wgid / 8; wgid = (xcd < r ? xcd * (q + 1) : r * (q + 1) + (xcd - r) * q) + off; }
  const int nig = 8 * nN, gid = wgid / nig, fm = gid * 8, gsz = (nM - fm) < 8 ? (nM - fm) : 8;
  pm = fm + ((wgid % nig) % gsz); pn = (wgid % nig) / gsz;
  return true;
}

DI int colmap(int mode, int n) {
  if (mode == 1) { if (n < 3072) return n; if (n < 3104) return n + 1984; if (n < 5088) return n - 32; return n + 32; }
  if (mode == 2) { if (n < 2816) return (n >> 4) * 32 + (n & 15); const int j = n - 2816; return (j >> 4) * 32 + 16 + (j & 15); }
  return n;
}
DI void convert_wave_tile(const float* __restrict__ src, int K, int N, bf16_t* __restrict__ dst, int mode, const float* __restrict__ kscale,
                          int tile, float* wl, int lane) {
  const int ntn = N >> 4;
  const int tk = tile / ntn, tn = tile - tk * ntn;
  const int k0 = tk * 64, n0 = tn * 16;
  const float* sp = src + (size_t)(k0 + lane) * N + n0;
  const float4 v0 = *(const float4*)(sp), v1 = *(const float4*)(sp + 4), v2 = *(const float4*)(sp + 8), v3 = *(const float4*)(sp + 12);
  const float sc = kscale ? kscale[k0 + lane] : 1.0f;
  float* wr = wl + lane * 17;
  wr[0] = v0.x * sc; wr[1] = v0.y * sc; wr[2] = v0.z * sc; wr[3] = v0.w * sc; wr[4] = v1.x * sc; wr[5] = v1.y * sc; wr[6] = v1.z * sc; wr[7] = v1.w * sc;
  wr[8] = v2.x * sc; wr[9] = v2.y * sc; wr[10] = v2.z * sc; wr[11] = v2.w * sc; wr[12] = v3.x * sc; wr[13] = v3.y * sc; wr[14] = v3.z * sc; wr[15] = v3.w * sc;
  __builtin_amdgcn_fence(__ATOMIC_RELEASE, "wavefront");
  __builtin_amdgcn_wave_barrier();
  __builtin_amdgcn_fence(__ATOMIC_ACQUIRE, "wavefront");
  const int n = lane >> 2, kq = (lane & 3) * 16;
  const int np = colmap(mode, n0 + n);
  u32x4 o0, o1;
#pragma unroll
  for (int j = 0; j < 4; ++j) { o0[j] = pk2(wl[(kq + 2 * j) * 17 + n], wl[(kq + 2 * j + 1) * 17 + n]); o1[j] = pk2(wl[(kq + 8 + 2 * j) * 17 + n], wl[(kq + 9 + 2 * j) * 17 + n]); }
  bf16_t* dp = dst + (size_t)np * K + k0 + kq;
  *(u32x4*)(dp) = o0; *(u32x4*)(dp + 8) = o1;
  __builtin_amdgcn_fence(__ATOMIC_RELEASE, "wavefront");
  __builtin_amdgcn_wave_barrier();
  __builtin_amdgcn_fence(__ATOMIC_ACQUIRE, "wavefront");
}

DI void norm_phase(const Params& p, int l, int which, int b0, int nb, const float* xsrc, const float* csrc, bf16_t* H, bool skipctx) {
  const int tid = opaque_tid(), lane = tid & 63, w = tid >> 6;
  const float* MOD = (const float*)(p.ws + OFF_MOD);
  const float* gain = (which ? p.norm_ffn : p.norm_mix) + l * 1024;
  const int rows = nb * TT;
  for (int r = blockIdx.x * 8 + w; r < rows; r += gridDim.x * 8) {
    const int bl = r / TT, t = r - bl * TT, b = b0 + bl;
    if (t >= 2048 && skipctx) continue;
    const float* src = (t < 2048) ? xsrc + ((size_t)b * 2048 + t) * 1024 : csrc + ((size_t)b * 256 + (t - 2048)) * 1024;
    const float* mrow = MOD + (size_t)(l * 9 + (t < 2048 ? b : 8)) * 6144 + which * 3072;
    float4 v[4]; float ss = 0.f;
#pragma unroll
    for (int i = 0; i < 4; ++i) { v[i] = *(const float4*)(src + lane * 4 + 256 * i); ss += v[i].x * v[i].x + v[i].y * v[i].y + v[i].z * v[i].z + v[i].w * v[i].w; }
#pragma unroll
    for (int o = 32; o >= 1; o >>= 1) ss += shx(ss, lane, o);
    const float rstd = rsqrtf(ss * (1.0f / 1024.0f) + 1e-6f);
#pragma unroll
    for (int i = 0; i < 4; ++i) {
      const int col = lane * 4 + 256 * i;
      const float4 g = *(const float4*)(gain + col), sh = *(const float4*)(mrow + col), sc = *(const float4*)(mrow + 1024 + col);
      f32x4 o;
      o[0] = v[i].x * rstd * g.x * (1.f + sc.x) + sh.x; o[1] = v[i].y * rstd * g.y * (1.f + sc.y) + sh.y;
      o[2] = v[i].z * rstd * g.z * (1.f + sc.z) + sh.z; o[3] = v[i].w * rstd * g.w * (1.f + sc.w) + sh.w;
      *(u32x2*)(H + (size_t)r * 1024 + col) = pk4(o);
    }
  }
}

DI void rope_acc(f32x4 (&acc)[4][4], const float2* __restrict__ rope, int t0  , int l15, int quad) {
#pragma unroll
  for (int mt = 0; mt < 4; ++mt) {
    const int t = t0 + mt * 16 + l15;
    const int prow = t >> 6, pcol = t & 63;
    const float4* rpr = (const float4*)(rope + prow * 16 + quad * 4);
    const float4* rpc = (const float4*)(rope + pcol * 16 + quad * 4);
    const float4 r01 = rpr[0], r23 = rpr[1], c01 = rpc[0], c23 = rpc[1];
#pragma unroll
    for (int i = 0; i < 4; ++i) {
      const float2 cr = i == 0 ? make_float2(r01.x, r01.y) : i == 1 ? make_float2(r01.z, r01.w) : i == 2 ? make_float2(r23.x, r23.y) : make_float2(r23.z, r23.w);
      const float2 cc = i == 0 ? make_float2(c01.x, c01.y) : i == 1 ? make_float2(c01.z, c01.w) : i == 2 ? make_float2(c23.x, c23.y) : make_float2(c23.z, c23.w);
      const float a1 = acc[mt][0][i], a2 = acc[mt][1][i];
      acc[mt][0][i] = a1 * cr.x - a2 * cr.y; acc[mt][1][i] = a2 * cr.x + a1 * cr.y;
      const float b1 = acc[mt][2][i], b2 = acc[mt][3][i];
      acc[mt][2][i] = b1 * cc.x - b2 * cc.y; acc[mt][3][i] = b2 * cc.x + b1 * cc.y;
    }
    asm volatile("" ::: "memory");
  }
}
DI void store_rows_direct(const f32x4 (&acc)[4][4], bf16_t* dst, int ld, int wm, int l15, int quad, float scale) {
#pragma unroll
  for (int mt = 0; mt < 4; ++mt) {
    bf16_t* rp = dst + (size_t)(wm * 64 + mt * 16 + l15) * ld + quad * 4;
#pragma unroll
    for (int nt = 0; nt < 4; ++nt) *(u32x2*)(rp + nt * 16) = pk4(acc[mt][nt] * scale);
  }
}
template <int NT>
DI void stage_rows(const f32x4 (&v)[4][NT], unsigned char* lds, bf16_t* dst, int ld, float scale) {
  const int tid = opaque_tid(), lane = tid & 63, w = tid >> 6, wm = w >> 1, wn = w & 1, l15 = lane & 15, quad = lane >> 4;
  constexpr int NC = NT * 32, RS = (NC + 8) * 2, CH = NC / 8, PER = (256 * CH) / 512;
#pragma unroll
  for (int mt = 0; mt < 4; ++mt)
#pragma unroll
    for (int nt = 0; nt < NT; ++nt)
      *(u32x2*)(lds + (wm * 64 + mt * 16 + l15) * RS + (wn * NT * 16 + nt * 16 + quad * 4) * 2) = pk4(v[mt][nt] * scale);
  LDS_BARRIER();
#pragma unroll
  for (int i = 0; i < PER; ++i) {
    const int id = tid + 512 * i, row = id / CH, ch = id % CH;
    const u32x4 x = *(const u32x4*)(lds + row * RS + ch * 16);
    *(u32x4*)(dst + (size_t)row * ld + ch * 8) = x;
  }
  LDS_BARRIER();
}
DI void stage_cols(const f32x4 (&v)[4][4], unsigned char* lds, bf16_t* dst) {
  const int tid = opaque_tid(), lane = tid & 63, w = tid >> 6, wm = w >> 1, wn = w & 1, l15 = lane & 15, quad = lane >> 4;
#pragma unroll
  for (int mt = 0; mt < 4; ++mt)
#pragma unroll
    for (int nt = 0; nt < 4; ++nt)
      *(u32x2*)(lds + (wn * 64 + nt * 16 + l15) * 528 + (wm * 64 + mt * 16 + quad * 4) * 2) = pk4(v[mt][nt]);
  LDS_BARRIER();
#pragma unroll
  for (int i = 0; i < 8; ++i) {
    const int id = tid + 512 * i, row = id >> 5, ch = id & 31;
    const u32x4 x = *(const u32x4*)(lds + row * 528 + ch * 16);
    *(u32x4*)(dst + (size_t)row * TT + ch * 8) = x;
  }
  LDS_BARRIER();
}

DI void inproj_epi(const Params& p, f32x4 (&acc)[4][4], int tm, int tn, unsigned char* lds) {
  unsigned char* act = p.ws + OFF_ACT;
  const float2* rope = (const float2*)(p.ws + OFF_ROPE);
  const int bl = tm / 9, tt = tm - bl * 9;
  const bool latent = tt < 8;
  const int r0 = tm * 256, t0 = tt * 256;
  {
    const int tid = opaque_tid(), lane = tid & 63, w = tid >> 6, wm = w >> 1, wn = w & 1, l15 = lane & 15, quad = lane >> 4;
    const int wt0 = t0 + wm * 64;
    if (tn < 4) {
      stage_rows<4>(acc, lds, (bf16_t*)(act + A_GQK) + (size_t)r0 * 1024 + tn * 128, 1024, 0.08838834764831845f);
    } else if (tn < 8) {
      stage_rows<4>(acc, lds, (bf16_t*)(act + A_GQK) + (size_t)r0 * 1024 + 512 + (tn - 4) * 128, 1024, 1.0f);
    } else if (tn < 16) {
      stage_cols(acc, lds, (bf16_t*)(act + A_GVT) + ((size_t)bl * 1024 + (tn - 8) * 128) * TT + t0);
    } else if (tn < 24) {
      stage_rows<4>(acc, lds, (bf16_t*)(act + A_GG) + (size_t)r0 * 1024 + (tn - 16) * 128, 1024, 1.0f);
    } else if (tn < 32) {
      if (latent) rope_acc(acc, rope, wt0, l15, quad);
      stage_rows<4>(acc, lds, (bf16_t*)(act + A_SQ) + (size_t)r0 * 1024 + (tn - 24) * 128, 1024, 0.125f * LOG2E);
    } else if (tn == 32) {
      if (latent) rope_acc(acc, rope, wt0, l15, quad);
      stage_rows<4>(acc, lds, (bf16_t*)(act + A_SK) + (size_t)r0 * 128, 128, 1.0f);
    } else if (tn == 33) {
      stage_cols(acc, lds, (bf16_t*)(act + A_SVT) + ((size_t)bl * 128) * TT + t0);
    } else if (tn < 39) {
      float* rsq = (float*)(p.ws + OFF_RSQ) + (tn < 37 ? 0 : R) + r0;
#pragma unroll
      for (int mt = 0; mt < 4; ++mt) {
        float ss = 0.f;
#pragma unroll
        for (int nt = 0; nt < 4; ++nt) { const f32x4 v = acc[mt][nt]; ss += v[0] * v[0] + v[1] * v[1] + v[2] * v[2] + v[3] * v[3]; }
        ss += shx(ss, lane, 16); ss += shx(ss, lane, 32);
        if (quad == 0) atomicAdd(rsq + wm * 64 + mt * 16 + l15, ss);
      }
      if (tn < 37) stage_rows<4>(acc, lds, (bf16_t*)(act + A_CQ) + (size_t)r0 * 384 + (tn - 34) * 128, 384, 1.0f);
      else stage_rows<4>(acc, lds, (bf16_t*)(act + A_CKV) + (size_t)r0 * 256 + (tn - 37) * 128, 256, 1.0f);
    } else if (tn == 39) {
      if (wn == 0) {
        if (latent) rope_acc(acc, rope, wt0, l15, quad);
        store_rows_direct(acc, (bf16_t*)(act + A_KR) + (size_t)r0 * 64, 64, wm, l15, quad, 1.0f);
      } else {
        float* gkr = (float*)(act + A_GKR);
#pragma unroll
        for (int mt = 0; mt < 4; ++mt)
#pragma unroll
          for (int nt = 0; nt < 2; ++nt)
            *(f32x4*)(gkr + (size_t)(r0 + wm * 64 + mt * 16 + l15) * 32 + nt * 16 + quad * 4) = acc[mt][nt];
      }
    } else {
#pragma unroll
      for (int mt = 0; mt < 4; ++mt)
#pragma unroll
        for (int nt = 0; nt < 4; ++nt) {
          f32x4 v = acc[mt][nt];
          v[0] = fmaxf(sigmoidf_(v[0]), 1e-6f); v[1] = fmaxf(sigmoidf_(v[1]), 1e-6f); v[2] = fmaxf(sigmoidf_(v[2]), 1e-6f); v[3] = fmaxf(sigmoidf_(v[3]), 1e-6f);
          acc[mt][nt] = v;
        }
      stage_rows<4>(acc, lds, (bf16_t*)(act + A_MG) + (size_t)r0 * 3072 + (tn - 40) * 128, 3072, 1.0f);
    }
  }
}
DI void inproj_phase(const Params& p, int g, unsigned char* lds) {
  unsigned char* act = p.ws + OFF_ACT;
  const bf16_t* H = (const bf16_t*)(act + A_H);
  const bf16_t* W = (const bf16_t*)(p.ws + OFF_WM + WM_WIN);
  const int nunits = (R / 256) * 33;
  (void)nunits;
  for (int i_ = 0;; ++i_) {
    int tm, u;
    if (!unit_order(i_, R / 256, 33, tm, u)) break;
    const int r0 = tm * 256;
    if (u < 31) {
      const int tn0 = 2 * (u < 16 ? u : u + 1);
      f32x4 acc0[4][4], acc1[4][4]; zero_acc(acc0); zero_acc(acc1);
      if (tn0 >= 8 && tn0 < 16) gemm_tile2<false>(H + (size_t)r0 * 1024, 1024, W + (size_t)tn0 * 128 * 1024, 1024, 1024, lds, acc0, acc1);
      else gemm_tile2<true>(H + (size_t)r0 * 1024, 1024, W + (size_t)tn0 * 128 * 1024, 1024, 1024, lds, acc0, acc1);
      inproj_epi(p, acc0, tm, tn0, lds);
      inproj_epi(p, acc1, tm, tn0 + 1, lds);
    } else {
      const int tn = u + 1;
      f32x4 acc[4][4]; zero_acc(acc);
      if (tn == 33) gemm_tile<false, false>(H + (size_t)r0 * 1024, 1024, W + (size_t)tn * 128 * 1024, 1024, 1024, lds, acc);
      else gemm_tile<true, false>(H + (size_t)r0 * 1024, 1024, W + (size_t)tn * 128 * 1024, 1024, 1024, lds, acc);
      inproj_epi(p, acc, tm, tn, lds);
    }
  }
}

template <int K>
DI void row_rstd(const bf16_t* __restrict__ A, float* rs, int tid) {
  const int row = tid >> 1, half = tid & 1;
  const bf16_t* ap = A + (size_t)row * K + half * (K / 2);
  float ss = 0.f;
#pragma unroll 4
  for (int c = 0; c < K / 16; ++c) {
    const u32x4 v = *(const u32x4*)(ap + c * 8);
#pragma unroll
    for (int j = 0; j < 4; ++j) { const float a = bflo(v[j]), b = bfhi(v[j]); ss += a * a + b * b; }
  }
  ss += shx(ss, tid & 63, 1);
  if (half == 0) rs[row] = rsqrtf(ss / (float)K + 1e-6f);
}
DI void mlaup_phase(const Params& p, bool last, unsigned char* lds) {
  unsigned char* act = p.ws + OFF_ACT;
  const float2* rope = (const float2*)(p.ws + OFF_ROPE);
  const float* rsq_q = (const float*)(p.ws + OFF_RSQ);
  const float* rsq_kv = rsq_q + R;
  const int nrt_q = last ? BG * 8 : BG * 9;
  const int nq = nrt_q * 12, nkv = (R / 256) * 16;
  const int G_ = gridDim.x, b_ = blockIdx.x;
  for (int id = b_; id < nq; id += G_) {
    const int tid = opaque_tid(), lane = tid & 63, w = tid >> 6, wm = w >> 1, wn = w & 1, l15 = lane & 15, quad = lane >> 4;
    const int rt = id / 12, tn = id - rt * 12;
    const int tm = last ? (rt / 8) * 9 + (rt & 7) : rt;
    const int bl = tm / 9, tt = tm - bl * 9;
    const bool latent = tt < 8;
    const int r0 = tm * 256, t0 = tt * 256;
    const bf16_t* A = (const bf16_t*)(act + A_CQ) + (size_t)r0 * 384;
    f32x4 acc[4][4]; zero_acc(acc);
    gemm_tile<true, false>(A, 384, (const bf16_t*)(p.ws + OFF_WM + WM_WQU) + (size_t)tn * 128 * 384, 384, 384, lds, acc);
    const float sc = 0.07216878364870322f * LOG2E;
#pragma unroll
    for (int mt = 0; mt < 4; ++mt) { const float rv = rsqrtf(rsq_q[r0 + wm * 64 + mt * 16 + l15] * (1.0f / 384.0f) + 1e-6f) * sc;
#pragma unroll
      for (int nt = 0; nt < 4; ++nt) acc[mt][nt] *= rv; }
    const int g64 = tn * 2 + wn;
    if ((g64 % 3) == 2 && latent) rope_acc(acc, rope, t0 + wm * 64, l15, quad);
    stage_rows<4>(acc, lds, (bf16_t*)(act + A_QF) + (size_t)r0 * 1536 + tn * 128, 1536, 1.0f);
    __syncthreads();
  }
  for (int gid = b_ + ((nq - b_ + G_ - 1) / G_) * G_; gid < nq + nkv; gid += G_) {
    const int id = gid - nq;
    const int tid = opaque_tid(), lane = tid & 63, w = tid >> 6, wm = w >> 1, wn = w & 1, l15 = lane & 15, quad = lane >> 4;
    const int tm = id >> 4, tn = id & 15;
    const int bl = tm / 9, tt = tm - bl * 9;
    const int r0 = tm * 256, t0 = tt * 256;
    const bf16_t* A = (const bf16_t*)(act + A_CKV) + (size_t)r0 * 256;
    f32x4 acc[4][4]; zero_acc(acc);
    const bf16_t* W = (const bf16_t*)(p.ws + OFF_WM + WM_WKVU) + (size_t)tn * 128 * 256;
    if (tn & 1) {
      gemm_tile<false, false>(A, 256, W, 256, 256, lds, acc);
#pragma unroll
      for (int mt = 0; mt < 4; ++mt) {
        f32x4 rv = *(const f32x4*)(rsq_kv + r0 + wm * 64 + mt * 16 + quad * 4);
        rv[0] = rsqrtf(rv[0] * (1.0f / 256.0f) + 1e-6f); rv[1] = rsqrtf(rv[1] * (1.0f / 256.0f) + 1e-6f); rv[2] = rsqrtf(rv[2] * (1.0f / 256.0f) + 1e-6f); rv[3] = rsqrtf(rv[3] * (1.0f / 256.0f) + 1e-6f);
#pragma unroll
        for (int nt = 0; nt < 4; ++nt) acc[mt][nt] *= rv;
      }
      stage_cols(acc, lds, (bf16_t*)(act + A_VT) + ((size_t)bl * 1024 + (tn >> 1) * 128) * TT + t0);
    } else {
      gemm_tile<true, false>(A, 256, W, 256, 256, lds, acc);
#pragma unroll
      for (int mt = 0; mt < 4; ++mt) { const float rv = rsqrtf(rsq_kv[r0 + wm * 64 + mt * 16 + l15] * (1.0f / 256.0f) + 1e-6f);
#pragma unroll
        for (int nt = 0; nt < 4; ++nt) acc[mt][nt] *= rv; }
      stage_rows<4>(acc, lds, (bf16_t*)(act + A_KN) + (size_t)r0 * 1024 + (tn >> 1) * 128, 1024, 1.0f);
    }
    __syncthreads();
  }
}

template <int DKS, int NVT, int MT, bool MLA, bool HP = false>
DI void attn_item(const bf16_t* Qp, int ldq, bf16_t* Op, int ldo, const bf16_t* __restrict__ K1, int ldk1,
                  const bf16_t* __restrict__ K2, const bf16_t* __restrict__ Vt, int qrow0  , int qt0  ,
                  int krow0  , int ta0, int ta1, int tb0, int tb1, bool maskwin, bool has_sink, const float* sinkp,
                  unsigned char* lds) {
  constexpr int DK = DKS * 32, DV = NVT * 16, KSTR = DK * 2, KCH = DK / 8, KBYTES = 64 * KSTR, VBYTES = DV * 144, BUFB = KBYTES + VBYTES;
  const int tid = opaque_tid(), lane = tid & 63, w = tid >> 6, l15 = lane & 15, quad = lane >> 4;
  bf16x8 qf[MT][DKS];
#pragma unroll
  for (int mt = 0; mt < MT; ++mt)
#pragma unroll
    for (int ks = 0; ks < DKS; ++ks)
      qf[mt][ks] = *(const bf16x8*)(Qp + (size_t)(qrow0 + (HP ? w * 16 : w * 16 * MT + mt * 16) + l15) * ldq + (HP ? mt * 64 : 0) + ks * 32 + quad * 8);
  f32x4 o[MT][NVT];
  float mrow[MT], lrow[MT];
#pragma unroll
  for (int mt = 0; mt < MT; ++mt) {
    mrow[mt] = has_sink ? sinkp[HP ? mt : 0] * LOG2E : -INFINITY;
    lrow[mt] = (has_sink && quad == 0) ? 1.0f : 0.0f;
#pragma unroll
    for (int nv = 0; nv < NVT; ++nv) o[mt][nv] = (f32x4){0.f, 0.f, 0.f, 0.f};
  }
  const int na = ta1 - ta0, ntl = na + (tb1 - tb0);
  constexpr int NKL = (64 * KCH) / 512;
  constexpr int NVL = (DV * 8) / 512;
  u32x4 rk[NKL], rv[NVL];
#define AT_LOAD(J) do { const int kt_ = (J) < na ? ta0 + (J) : tb0 + ((J) - na); const size_t kr0_ = (size_t)krow0 + (size_t)kt_ * 64; \
    _Pragma("unroll") for (int i = 0; i < NKL; ++i) { const int idx = tid + 512 * i, key = idx / KCH, cc = idx - key * KCH; \
      if (MLA) rk[i] = (cc < 16) ? *(const u32x4*)(K1 + (kr0_ + key) * ldk1 + cc * 8) : *(const u32x4*)(K2 + (kr0_ + key) * 64 + (cc - 16) * 8); \
      else rk[i] = *(const u32x4*)(K1 + (kr0_ + key) * ldk1 + cc * 8); } \
    _Pragma("unroll") for (int i = 0; i < NVL; ++i) { const int idx = tid + 512 * i, dv = idx >> 3, cc = idx & 7; \
      rv[i] = *(const u32x4*)(Vt + (size_t)dv * TT + kt_ * 64 + cc * 8); } } while (0)
#define AT_STORE(BUF) do { unsigned char* ks_ = lds + (BUF) * BUFB; unsigned char* vs_ = ks_ + KBYTES; \
    _Pragma("unroll") for (int i = 0; i < NKL; ++i) { const int idx = tid + 512 * i, key = idx / KCH, cc = idx - key * KCH; \
      *(u32x4*)(ks_ + key * KSTR + (((cc & ~7) | ((cc & 7) ^ ((key >> 1) & 7))) * 16)) = rk[i]; } \
    _Pragma("unroll") for (int i = 0; i < NVL; ++i) { const int idx = tid + 512 * i, dv = idx >> 3, cc = idx & 7; *(u32x4*)(vs_ + dv * 144 + cc * 16) = rv[i]; } } while (0)
  AT_LOAD(0);
  AT_STORE(0);
  if (ntl > 1) AT_LOAD(1);
  LDS_BARRIER();
  const int ksw = (l15 >> 1) & 7;
  for (int j = 0; j < ntl; ++j) {
    const unsigned char* Ks = lds + (j & 1) * BUFB;
    const unsigned char* Vs = Ks + KBYTES;
    const int kt = j < na ? ta0 + j : tb0 + (j - na);
    const bool masked = maskwin && (j < na);
    f32x4 s[MT][4];
#pragma unroll
    for (int mt = 0; mt < MT; ++mt)
#pragma unroll
      for (int nt = 0; nt < 4; ++nt) s[mt][nt] = (f32x4){0.f, 0.f, 0.f, 0.f};
#pragma unroll
    for (int nt = 0; nt < 4; ++nt)
#pragma unroll
      for (int ks = 0; ks < DKS; ++ks) {
        const int cc = ks * 4 + quad;
        const bf16x8 kf = *(const bf16x8*)(Ks + (nt * 16 + l15) * KSTR + (((cc & ~7) | ((cc & 7) ^ ksw)) * 16));
#pragma unroll
        for (int mt = 0; mt < MT; ++mt) s[mt][nt] = MFMA16(kf, qf[mt][ks], s[mt][nt]);
      }
    bf16x8 pb[MT][2];
#pragma unroll
    for (int mt = 0; mt < MT; ++mt) {
      if (masked) {
        const int tq = qt0 + (HP ? w * 16 : w * 16 * MT + mt * 16) + l15;
#pragma unroll
        for (int nt = 0; nt < 4; ++nt)
#pragma unroll
          for (int i = 0; i < 4; ++i) {
            const int d = kt * 64 + nt * 16 + quad * 4 + i - tq;
            if (d > 128 || d < -128) s[mt][nt][i] = -INFINITY;
          }
      }
      float mx = s[mt][0][0];
#pragma unroll
      for (int nt = 0; nt < 4; ++nt)
#pragma unroll
        for (int i = 0; i < 4; ++i) mx = fmaxf(mx, s[mt][nt][i]);
      mx = fmaxf(mx, shx(mx, lane, 16));
      mx = fmaxf(mx, shx(mx, lane, 32));
      const float mnew = fmaxf(mrow[mt], mx);
      const float alpha = (mnew == -INFINITY) ? 1.0f : __builtin_amdgcn_exp2f(mrow[mt] - mnew);
      const float msub = (mnew == -INFINITY) ? 0.0f : mnew;
      mrow[mt] = mnew;
      float ps = 0.f;
#pragma unroll
      for (int nt = 0; nt < 4; ++nt)
#pragma unroll
        for (int i = 0; i < 4; ++i) { const float pv = __builtin_amdgcn_exp2f(s[mt][nt][i] - msub); s[mt][nt][i] = pv; ps += pv; }
      lrow[mt] = lrow[mt] * alpha + ps;
      if (__any(alpha != 1.0f)) {
#pragma unroll
        for (int nv = 0; nv < NVT; ++nv) o[mt][nv] *= alpha;
      }
#pragma unroll
      for (int k2 = 0; k2 < 2; ++k2) {
        u32x4 pw;
        pw[0] = pk2(s[mt][2 * k2][0], s[mt][2 * k2][1]); pw[1] = pk2(s[mt][2 * k2][2], s[mt][2 * k2][3]);
        pw[2] = pk2(s[mt][2 * k2 + 1][0], s[mt][2 * k2 + 1][1]); pw[3] = pk2(s[mt][2 * k2 + 1][2], s[mt][2 * k2 + 1][3]);
        pb[mt][k2] = __builtin_bit_cast(bf16x8, pw);
      }
    }
#pragma unroll
    for (int nv = 0; nv < NVT; ++nv)
#pragma unroll
      for (int k2 = 0; k2 < 2; ++k2) {
        const s16x4 lo = *(const s16x4*)(Vs + (nv * 16 + l15) * 144 + k2 * 64 + quad * 8);
        const s16x4 hi = *(const s16x4*)(Vs + (nv * 16 + l15) * 144 + k2 * 64 + 32 + quad * 8);
        const bf16x8 vf = __builtin_shufflevector(lo, hi, 0, 1, 2, 3, 4, 5, 6, 7);
#pragma unroll
        for (int mt = 0; mt < MT; ++mt) o[mt][nv] = MFMA16(vf, pb[mt][k2], o[mt][nv]);
      }
    if (j + 1 < ntl) {
      AT_STORE((j + 1) & 1);
      if (j + 2 < ntl) AT_LOAD(j + 2);
    }
    LDS_BARRIER();
  }
#undef AT_LOAD
#undef AT_STORE
  {
    constexpr int OC = HP ? MT * 64 : DV, ORS = (OC + 8) * 2, OROWS = HP ? 128 : 128 * MT, OCH = OC / 8, OPER = (OROWS * OCH) / 512;
#pragma unroll
    for (int mt = 0; mt < MT; ++mt) {
      float lt = lrow[mt];
      lt += shx(lt, lane, 16);
      lt += shx(lt, lane, 32);
      const float inv = 1.0f / lt;
      const int rowl = (HP ? w * 16 : w * 16 * MT + mt * 16) + l15;
      unsigned char* orow = lds + rowl * ORS + ((HP ? mt * 64 : 0) + quad * 4) * 2;
#pragma unroll
      for (int nv = 0; nv < NVT; ++nv) *(u32x2*)(orow + nv * 32) = pk4(o[mt][nv] * inv);
    }
    LDS_BARRIER();
#pragma unroll
    for (int i = 0; i < OPER; ++i) {
      const int id = tid + 512 * i, row = id / OCH, ch = id - row * OCH;
      const u32x4 x = *(const u32x4*)(lds + row * ORS + ch * 16);
      *(u32x4*)(Op + (size_t)(qrow0 + row) * ldo + ch * 8) = x;
    }
  }
  __syncthreads();
}

DI void gla_chain(const Params& p, int l, int bl, int h, int sl, int dir, unsigned char* lds) {
  unsigned char* act = p.ws + OFF_ACT;
  const bf16_t* GQK = (const bf16_t*)(act + A_GQK);
  const bf16_t* GVT = (const bf16_t*)(act + A_GVT);
  const float* GKR = (const float*)(act + A_GKR);
  bf16_t* OUT = (bf16_t*)(act + (dir ? A_OB : A_H));
  unsigned char* QD = lds + L_QD; unsigned char* KI = lds + L_KI; unsigned char* KET = lds + L_KET; unsigned char* VTs = lds + L_VT; unsigned char* STs = lds + L_ST;
  float* WG = (float*)(lds + L_WG); float* BGs = (float*)(lds + L_BG); float* ETOT = (float*)(lds + L_ETOT);
  const int tid = opaque_tid(), lane = tid & 63, w = tid >> 6, l15 = lane & 15, quad = lane >> 4;
  {
    const float* wg = (dir ? p.w_gk_bwd : p.w_gk_fwd) + (size_t)l * 16 * 512 + h * 128;
    const float* bgp = (dir ? p.b_gk_bwd : p.b_gk_fwd) + (size_t)l * 512 + h * 128;
    for (int i = tid; i < 2048; i += 512) WG[i] = wg[(i >> 7) * 512 + (i & 127)];
    if (tid < 128) BGs[tid] = bgp[tid];
    for (int i = tid; i < 17408 / 4; i += 512) ((unsigned*)STs)[i] = 0u;
  }
  f32x4 S[4];
#pragma unroll
  for (int i = 0; i < 4; ++i) S[i] = (f32x4){0.f, 0.f, 0.f, 0.f};
  u32x4 rq0, rq1, rk0, rk1, rvv; float4 g0, g1, g2, g3;
  const int vv_ = tid >> 3, vch_ = tid & 7;
#define GLA_LOAD(U) do { const int row0_ = bl * TT + (U) * 64; \
    const bf16_t* qp_ = GQK + (size_t)(row0_ + lane) * 1024 + h * 128 + w * 16; \
    rq0 = *(const u32x4*)(qp_); rq1 = *(const u32x4*)(qp_ + 8); rk0 = *(const u32x4*)(qp_ + 512); rk1 = *(const u32x4*)(qp_ + 520); \
    rvv = *(const u32x4*)(GVT + ((size_t)bl * 1024 + h * 256 + sl * 64 + vv_) * TT + (U) * 64 + vch_ * 8); \
    const float* gp_ = GKR + (size_t)(row0_ + lane) * 32 + dir * 16; \
    g0 = *(const float4*)(gp_); g1 = *(const float4*)(gp_ + 4); g2 = *(const float4*)(gp_ + 8); g3 = *(const float4*)(gp_ + 12); } while (0)
  GLA_LOAD(dir ? 35 : 32);
  __syncthreads();
  for (int step = 0; step < 36; ++step) {
    const int u = dir ? (35 - step) : (step < 4 ? 32 + step : step - 4);
    const int row0 = bl * TT + u * 64;
    LDS_BARRIER();
    {
      const float gk[16] = {g0.x, g0.y, g0.z, g0.w, g1.x, g1.y, g1.z, g1.w, g2.x, g2.y, g2.z, g2.w, g3.x, g3.y, g3.z, g3.w};
      f32x2_t z2[8];
#pragma unroll
      for (int j4 = 0; j4 < 4; ++j4) { const float4 bv = *(const float4*)(BGs + w * 16 + j4 * 4); z2[2 * j4] = (f32x2_t){bv.x, bv.y}; z2[2 * j4 + 1] = (f32x2_t){bv.z, bv.w}; }
#pragma unroll
      for (int r = 0; r < 16; ++r) {
        const f32x2_t g2 = (f32x2_t){gk[r], gk[r]};
#pragma unroll
        for (int j4 = 0; j4 < 4; ++j4) {
          const float4 wv = *(const float4*)(WG + r * 128 + w * 16 + j4 * 4);
          z2[2 * j4] = g2 * (f32x2_t){wv.x, wv.y} + z2[2 * j4];
          z2[2 * j4 + 1] = g2 * (f32x2_t){wv.z, wv.w} + z2[2 * j4 + 1];
        }
      }
      float la[16], x[16];
#pragma unroll
      for (int j = 0; j < 16; ++j) {
        const float z = (j & 1) ? z2[j >> 1][1] : z2[j >> 1][0];
        const float t = __builtin_amdgcn_exp2f(-fabsf(z) * LOG2E);
        la[j] = (fminf(z, 0.f) - __builtin_amdgcn_logf(1.0f + t) * 0.6931471805599453f) * (1.0f / 16.0f);
        x[j] = la[j];
      }
#pragma unroll
      for (int j = 0; j < 16; ++j) x[j] += dpp_move<0x111, 0xF, true>(x[j]);
#pragma unroll
      for (int j = 0; j < 16; ++j) x[j] += dpp_move<0x112, 0xF, true>(x[j]);
#pragma unroll
      for (int j = 0; j < 16; ++j) x[j] += dpp_move<0x114, 0xF, true>(x[j]);
#pragma unroll
      for (int j = 0; j < 16; ++j) x[j] += dpp_move<0x118, 0xF, true>(x[j]);
#pragma unroll
      for (int j = 0; j < 16; ++j) x[j] += dpp_move<0x142, 0xA, false>(x[j]);
#pragma unroll
      for (int j = 0; j < 16; ++j) x[j] += dpp_move<0x143, 0xC, false>(x[j]);
      float qd[16], ki[16], et[16];
#pragma unroll
      for (int j = 0; j < 16; ++j) {
        const float tot = __builtin_bit_cast(float, __builtin_amdgcn_readlane(__builtin_bit_cast(int, x[j]), 63));
        const float cum = dir ? (tot - x[j] + la[j]) : x[j];
        const float e = __builtin_amdgcn_exp2f(cum * LOG2E);
        const float ie = __builtin_amdgcn_rcpf(e);
        const float etv = __builtin_amdgcn_exp2f(tot * LOG2E);
        et[j] = etv;
        const unsigned qw = (j < 8) ? rq0[(j & 7) >> 1] : rq1[(j & 7) >> 1];
        const unsigned kw = (j < 8) ? rk0[(j & 7) >> 1] : rk1[(j & 7) >> 1];
        const float qv = (j & 1) ? bfhi(qw) : bflo(qw);
        const float kv = (j & 1) ? bfhi(kw) : bflo(kw);
        qd[j] = qv * e; ki[j] = kv * ie;
        *(bf16_t*)(KET + ((w * 16 + j) * 72 + lane) * 2) = f2bf(kv * etv * ie);
      }
#pragma unroll
      for (int i = 0; i < 2; ++i) {
        u32x4 a, b;
#pragma unroll
        for (int j = 0; j < 4; ++j) { a[j] = pk2(qd[8 * i + 2 * j], qd[8 * i + 2 * j + 1]); b[j] = pk2(ki[8 * i + 2 * j], ki[8 * i + 2 * j + 1]); }
        *(u32x4*)(QD + (lane * 136 + w * 16 + 8 * i) * 2) = a;
        *(u32x4*)(KI + (lane * 136 + w * 16 + 8 * i) * 2) = b;
      }
      if (lane == 0) {
#pragma unroll
        for (int j4 = 0; j4 < 4; ++j4) *(f32x4*)(ETOT + w * 16 + j4 * 4) = (f32x4){et[4 * j4], et[4 * j4 + 1], et[4 * j4 + 2], et[4 * j4 + 3]};
      }
      *(u32x4*)(VTs + (vv_ * 72 + vch_ * 8) * 2) = rvv;
    }
    LDS_BARRIER();
    if (step + 1 < 36) { const int un = dir ? (34 - step) : (step + 1 < 4 ? 33 + step : step - 3); GLA_LOAD(un); }
    {
      const int ct = w & 3, vh = w >> 2;
      bf16x8 qdf[4];
#pragma unroll
      for (int ks = 0; ks < 4; ++ks) qdf[ks] = *(const bf16x8*)(QD + ((ct * 16 + l15) * 136 + ks * 32 + quad * 8) * 2);
      f32x4 sc[4];
#pragma unroll
      for (int nt = 0; nt < 4; ++nt) {
        sc[nt] = (f32x4){0.f, 0.f, 0.f, 0.f};
#pragma unroll
        for (int ks = 0; ks < 4; ++ks) {
          const bf16x8 kf = *(const bf16x8*)(KI + ((nt * 16 + l15) * 136 + ks * 32 + quad * 8) * 2);
          sc[nt] = MFMA16(kf, qdf[ks], sc[nt]);
        }
        const int cidx = ct * 16 + l15;
#pragma unroll
        for (int i = 0; i < 4; ++i) {
          const int sidx = nt * 16 + quad * 4 + i;
          const bool keep = dir ? (sidx > cidx) : (sidx <= cidx);
          if (!keep) sc[nt][i] = 0.f;
        }
      }
      bf16x8 pb[2];
#pragma unroll
      for (int k2 = 0; k2 < 2; ++k2) {
        u32x4 pw;
        pw[0] = pk2(sc[2 * k2][0], sc[2 * k2][1]); pw[1] = pk2(sc[2 * k2][2], sc[2 * k2][3]);
        pw[2] = pk2(sc[2 * k2 + 1][0], sc[2 * k2 + 1][1]); pw[3] = pk2(sc[2 * k2 + 1][2], sc[2 * k2 + 1][3]);
        pb[k2] = __builtin_bit_cast(bf16x8, pw);
      }
#pragma unroll
      for (int nv = 0; nv < 2; ++nv) {
        const int vrow = vh * 32 + nv * 16 + l15;
        f32x4 oo = (f32x4){0.f, 0.f, 0.f, 0.f};
#pragma unroll
        for (int k2 = 0; k2 < 2; ++k2) {
          const s16x4 lo = *(const s16x4*)(VTs + (vrow * 72 + k2 * 32 + quad * 4) * 2);
          const s16x4 hi = *(const s16x4*)(VTs + (vrow * 72 + k2 * 32 + 16 + quad * 4) * 2);
          const bf16x8 vf = __builtin_shufflevector(lo, hi, 0, 1, 2, 3, 4, 5, 6, 7);
          oo = MFMA16(vf, pb[k2], oo);
        }
#pragma unroll
        for (int ks = 0; ks < 4; ++ks) {
          const bf16x8 sf = *(const bf16x8*)(STs + (vrow * 136 + ks * 32 + quad * 8) * 2);
          oo = MFMA16(sf, qdf[ks], oo);
        }
        *(u32x2*)(OUT + (size_t)(row0 + ct * 16 + l15) * 1024 + h * 256 + sl * 64 + vh * 32 + nv * 16 + quad * 4) = pk4(oo);
      }
    }
    LDS_BARRIER();
    {
      const f32x4 dec = *(const f32x4*)(ETOT + w * 16 + quad * 4);
#pragma unroll
      for (int vt = 0; vt < 4; ++vt) S[vt] *= dec;
#pragma unroll
      for (int k2 = 0; k2 < 2; ++k2) {
        const bf16x8 kef = *(const bf16x8*)(KET + ((w * 16 + l15) * 72 + k2 * 32 + quad * 8) * 2);
#pragma unroll
        for (int vt = 0; vt < 4; ++vt) {
          const bf16x8 vf = *(const bf16x8*)(VTs + ((vt * 16 + l15) * 72 + k2 * 32 + quad * 8) * 2);
          S[vt] = MFMA16(kef, vf, S[vt]);
        }
      }
#pragma unroll
      for (int vt = 0; vt < 4; ++vt) *(u32x2*)(STs + ((vt * 16 + l15) * 136 + w * 16 + quad * 4) * 2) = pk4(S[vt]);
    }
  }
#undef GLA_LOAD
  __syncthreads();
}

DI void mixers_phase(const Params& p, int l, int g, bool last, unsigned char* lds) {
  unsigned char* act = p.ws + OFF_ACT;
  const int xcd = blockIdx.x & 7;
  unsigned* ctr = (unsigned*)(p.ws + OFF_CTR) + ((l * NGRP + g) * 8 + xcd);
  int* s_item = (int*)(lds + L_ITEM);
  const int n_gla = BG * 4 * 4 * 2, n_mla = BG * 8 * 8, n_swa = BG * 4 * 16, n_mlac = last ? 0 : BG * 8, n_swac = last ? 0 : BG * 16 * 2;
  const int total = n_gla + n_mla + n_swa + n_mlac + n_swac;
  for (;;) {
    if (opaque_tid() == 0) *s_item = (int)atomicAdd(ctr, 1u);
    __syncthreads();
    int it = *s_item;
    __syncthreads();
    if (it >= total / 8) break;
    if (it < n_gla / 8) {
      it += xcd * (n_gla / 8);
      const int dir = it & 1, sl = (it >> 1) & 3, h = (it >> 3) & 3, bl = it >> 5;
      gla_chain(p, l, bl, h, sl, dir, lds);
      continue;
    }
    it -= n_gla / 8;
    if (it < n_mla / 8) {
      it += xcd * (n_mla / 8);
      const int bl = it >> 6, h = (it >> 3) & 7, qb = it & 7;
      bf16_t* QF = (bf16_t*)(act + A_QF) + h * 192;
      attn_item<6, 8, 2, true>(QF, 1536, QF, 1536, (const bf16_t*)(act + A_KN) + h * 128, 1024, (const bf16_t*)(act + A_KR),
                               (const bf16_t*)(act + A_VT) + ((size_t)bl * 1024 + h * 128) * TT, bl * TT + qb * 256, qb * 256, bl * TT, 0, 36, 0, 0,
                               false, false, nullptr, lds);
      continue;
    }
    it -= n_mla / 8;
    if (it < n_swa / 8) {
      it += xcd * (n_swa / 8);
      const int bl = it >> 6, gk = (it >> 5) & 1, hh = (it >> 4) & 1, qi = it & 15, hq0 = gk * 8 + hh * 4;
      bf16_t* SQ = (bf16_t*)(act + A_SQ) + hq0 * 64;
      const int a0 = (2 * qi - 2) < 0 ? 0 : (2 * qi - 2), a1 = (2 * qi + 4) > 32 ? 32 : (2 * qi + 4);
      attn_item<2, 4, 4, false, true>(SQ, 1024, SQ, 1024, (const bf16_t*)(act + A_SK) + gk * 64, 128, nullptr,
                                      (const bf16_t*)(act + A_SVT) + ((size_t)bl * 128 + gk * 64) * TT, bl * TT + qi * 128, qi * 128, bl * TT, a0, a1, 32, 36,
                                      true, true, p.sinks + l * 16 + hq0, lds);
      continue;
    }
    it -= n_swa / 8;
    if (it < n_mlac / 8) {
      it += xcd * (n_mlac / 8);
      const int bl = it >> 3, h = it & 7;
      bf16_t* QF = (bf16_t*)(act + A_QF) + h * 192;
      attn_item<6, 8, 2, true>(QF, 1536, QF, 1536, (const bf16_t*)(act + A_KN) + h * 128, 1024, (const bf16_t*)(act + A_KR),
                               (const bf16_t*)(act + A_VT) + ((size_t)bl * 1024 + h * 128) * TT, bl * TT + 2048, 2048, bl * TT, 32, 36, 0, 0,
                               false, false, nullptr, lds);
      continue;
    }
    it -= n_mlac / 8;
    {
      it += xcd * (n_swac / 8);
      const int bl = it >> 5, hq = (it >> 1) & 15, half = it & 1, gk = hq >> 3;
      bf16_t* SQ = (bf16_t*)(act + A_SQ) + hq * 64;
      attn_item<2, 4, 1, false>(SQ, 1024, SQ, 1024, (const bf16_t*)(act + A_SK) + gk * 64, 128, nullptr,
                                (const bf16_t*)(act + A_SVT) + ((size_t)bl * 128 + gk * 64) * TT, bl * TT + 2048 + half * 128, 2048 + half * 128, bl * TT,
                                32, 36, 0, 0, false, true, p.sinks + l * 16 + hq, lds);
    }
  }
}

DI void glapost_phase(const Params& p, int l) {
  unsigned char* act = p.ws + OFF_ACT;
  const bf16_t* OF = (const bf16_t*)(act + A_H);
  const bf16_t* OB = (const bf16_t*)(act + A_OB);
  bf16_t* GG = (bf16_t*)(act + A_GG);
  const float* gn = p.gla_norm + l * 256;
  const int tid = opaque_tid(), lane = tid & 63, w = tid >> 6;
  for (int r = blockIdx.x * 8 + w; r < R; r += gridDim.x * 8) {
    const size_t off = (size_t)r * 1024 + lane * 16;
    float v[16];
    float ss = 0.f;
#pragma unroll
    for (int c = 0; c < 2; ++c) {
      const u32x4 a = *(const u32x4*)(OF + off + c * 8), b = *(const u32x4*)(OB + off + c * 8);
#pragma unroll
      for (int j = 0; j < 4; ++j) { v[c * 8 + 2 * j] = bflo(a[j]) + bflo(b[j]); v[c * 8 + 2 * j + 1] = bfhi(a[j]) + bfhi(b[j]); }
    }
#pragma unroll
    for (int j = 0; j < 16; ++j) ss += v[j] * v[j];
#pragma unroll
    for (int o = 8; o >= 1; o >>= 1) ss += shx(ss, lane, o);
    const float rstd = rsqrtf(ss * (1.0f / 256.0f) + 1e-6f);
    const int vcol = (lane & 15) * 16;
#pragma unroll
    for (int c = 0; c < 2; ++c) {
      const u32x4 gq = *(const u32x4*)(GG + off + c * 8);
      u32x4 o;
#pragma unroll
      for (int j = 0; j < 4; ++j) {
        const float g0 = bflo(gq[j]), g1 = bfhi(gq[j]);
        const float y0 = v[c * 8 + 2 * j] * rstd * gn[vcol + c * 8 + 2 * j] * siluf_(g0);
        const float y1 = v[c * 8 + 2 * j + 1] * rstd * gn[vcol + c * 8 + 2 * j + 1] * siluf_(g1);
        o[j] = pk2(y0, y1);
      }
      *(u32x4*)(GG + off + c * 8) = o;
    }
  }
}

#define MERGE_SCALE_T(ACC, NTT, BR, COL0) do { \
      const int tid = opaque_tid(), lane = tid & 63, w = tid >> 6, wm = w >> 1, wn = w & 1, l15 = lane & 15, quad = lane >> 4; \
      const bf16_t* mg = (const bf16_t*)(act + A_MG) + (size_t)r0 * 3072 + (BR) * 1024 + (COL0) + wn * (NTT) * 16; \
      _Pragma("unroll") for (int mt = 0; mt < 4; ++mt) _Pragma("unroll") for (int nt = 0; nt < (NTT); ++nt) { \
          const bf16_t* gp = mg + (size_t)(wm * 64 + mt * 16 + l15) * 3072 + nt * 16 + quad * 4; \
          const u32x2 gw = *(const u32x2*)(gp); \
          f32x4 f = (f32x4){bflo(gw.x), bfhi(gw.x), bflo(gw.y), bfhi(gw.y)}; \
          if ((BR) < 2) { const u32x2 gn = *(const u32x2*)(gp + 1024); \
            f[0] *= __builtin_amdgcn_rcpf(bflo(gn.x)); f[1] *= __builtin_amdgcn_rcpf(bfhi(gn.x)); \
            f[2] *= __builtin_amdgcn_rcpf(bflo(gn.y)); f[3] *= __builtin_amdgcn_rcpf(bfhi(gn.y)); } \
          ACC[mt][nt] *= f; } } while (0)
DI void merge_phase(const Params& p, bool last, unsigned char* lds) {
  unsigned char* act = p.ws + OFF_ACT;
  for (int i_ = 0;; ++i_) {
    int rt, tn;
    if (!unit_order(i_, BG * 8, 8, rt, tn)) break;
    const int tm = (rt / 8) * 9 + (rt & 7);
    const int r0 = tm * 256;
    f32x4 acc[4][4]; zero_acc(acc);
    gemm_tile<true, false>((const bf16_t*)(act + A_GG) + (size_t)r0 * 1024, 1024, (const bf16_t*)(p.ws + OFF_WM + WM_WPA) + (size_t)tn * 128 * 1024, 1024, 1024, lds, acc);
    MERGE_SCALE_T(acc, 4, 0, tn * 128);
    gemm_tile<true, false>((const bf16_t*)(act + A_SQ) + (size_t)r0 * 1024, 1024, (const bf16_t*)(p.ws + OFF_WM + WM_WPB) + (size_t)tn * 128 * 1024, 1024, 1024, lds, acc);
    MERGE_SCALE_T(acc, 4, 1, tn * 128);
    gemm_tile<true, true>((const bf16_t*)(act + A_QF) + (size_t)r0 * 1536, 1536, (const bf16_t*)(p.ws + OFF_WM + WM_WPC) + (size_t)tn * 128 * 1024, 1024, 1024, lds, acc);
    MERGE_SCALE_T(acc, 4, 2, tn * 128);
    stage_rows<4>(acc, lds, (bf16_t*)(act + A_GQK) + (size_t)r0 * 1024 + tn * 128, 1024, 1.0f);
  }
  if (last) return;
  for (int id = blockIdx.x; id < BG * 16; id += gridDim.x) {
    const int tm = (id >> 4) * 9 + 8, t64 = id & 15;
    const int r0 = tm * 256;
    f32x4 acc[4][2];
#pragma unroll
    for (int a_ = 0; a_ < 4; ++a_) { acc[a_][0] = (f32x4){0.f, 0.f, 0.f, 0.f}; acc[a_][1] = (f32x4){0.f, 0.f, 0.f, 0.f}; }
    gemm_tile_n64<false>((const bf16_t*)(act + A_GG) + (size_t)r0 * 1024, 1024, (const bf16_t*)(p.ws + OFF_WM + WM_WPA) + (size_t)t64 * 64 * 1024, 1024, 1024, lds, acc);
    MERGE_SCALE_T(acc, 2, 0, t64 * 64);
    gemm_tile_n64<false>((const bf16_t*)(act + A_SQ) + (size_t)r0 * 1024, 1024, (const bf16_t*)(p.ws + OFF_WM + WM_WPB) + (size_t)t64 * 64 * 1024, 1024, 1024, lds, acc);
    MERGE_SCALE_T(acc, 2, 1, t64 * 64);
    gemm_tile_n64<true>((const bf16_t*)(act + A_QF) + (size_t)r0 * 1536, 1536, (const bf16_t*)(p.ws + OFF_WM + WM_WPC) + (size_t)t64 * 64 * 1024, 1024, 1024, lds, acc);
    MERGE_SCALE_T(acc, 2, 2, t64 * 64);
    stage_rows<2>(acc, lds, (bf16_t*)(act + A_GQK) + (size_t)r0 * 1024 + t64 * 64, 1024, 1.0f);
  }
}
#undef MERGE_SCALE_T

DI void resid_epilogue(const f32x4 (&acc)[4][4], const float* srcp, float* dstp, const float* gate, int wm, int l15, int quad) {
#pragma unroll
  for (int mt = 0; mt < 4; ++mt) {
    const size_t ro = (size_t)(wm * 64 + mt * 16 + l15) * 1024 + quad * 4;
#pragma unroll
    for (int nt = 0; nt < 4; ++nt) {
      const f32x4 xo = *(const f32x4*)(srcp + ro + nt * 16);
      const f32x4 gv = *(const f32x4*)(gate + nt * 16 + quad * 4);
      *(f32x4*)(dstp + ro + nt * 16) = xo + gv * acc[mt][nt];
    }
  }
}

DI void resid_epilogue2(const f32x4 (&acc)[4][2], const float* srcp, float* dstp, const float* gate, int wm, int l15, int quad) {
#pragma unroll
  for (int mt = 0; mt < 4; ++mt) {
    const size_t ro = (size_t)(wm * 64 + mt * 16 + l15) * 1024 + quad * 4;
#pragma unroll
    for (int nt = 0; nt < 2; ++nt) {
      const f32x4 xo = *(const f32x4*)(srcp + ro + nt * 16);
      const f32x4 gv = *(const f32x4*)(gate + nt * 16 + quad * 4);
      *(f32x4*)(dstp + ro + nt * 16) = xo + gv * acc[mt][nt];
    }
  }
}
DI void wo_phase(const Params& p, int l, int g, bool last, unsigned char* lds) {
  unsigned char* act = p.ws + OFF_ACT;
  const float* MOD = (const float*)(p.ws + OFF_MOD);
  float* XC = (float*)(p.ws + OFF_XC);
  for (int i_ = 0;; ++i_) {
    int rt, tn;
    if (!unit_order(i_, BG * 8, 8, rt, tn)) break;
    const int bl = rt >> 3, tt = rt & 7, tm = bl * 9 + tt, b = g * BG + bl;
    const int r0 = tm * 256;
    f32x4 acc[4][4]; zero_acc(acc);
    gemm_tile<true, false>((const bf16_t*)(act + A_GQK) + (size_t)r0 * 1024, 1024, (const bf16_t*)(p.ws + OFF_WM + WM_WO) + (size_t)tn * 128 * 1024, 1024, 1024, lds, acc);
    const int tid = opaque_tid(), lane = tid & 63, w = tid >> 6, wm = w >> 1, wn = w & 1, l15 = lane & 15, quad = lane >> 4;
    const int coff = tn * 128 + wn * 64;
    const size_t base = ((size_t)b * 2048 + tt * 256) * 1024 + coff;
    resid_epilogue(acc, (l == 0 ? p.x : p.out) + base, p.out + base, MOD + (size_t)(l * 9 + b) * 6144 + 2048 + coff, wm, l15, quad);
  }
  if (last) return;
  for (int id = blockIdx.x; id < BG * 16; id += gridDim.x) {
    const int bl = id >> 4, t64 = id & 15, tm = bl * 9 + 8, b = g * BG + bl;
    const int r0 = tm * 256;
    f32x4 acc[4][2];
#pragma unroll
    for (int a_ = 0; a_ < 4; ++a_) { acc[a_][0] = (f32x4){0.f, 0.f, 0.f, 0.f}; acc[a_][1] = (f32x4){0.f, 0.f, 0.f, 0.f}; }
    gemm_tile_n64<false>((const bf16_t*)(act + A_GQK) + (size_t)r0 * 1024, 1024, (const bf16_t*)(p.ws + OFF_WM + WM_WO) + (size_t)t64 * 64 * 1024, 1024, 1024, lds, acc);
    const int tid = opaque_tid(), lane = tid & 63, w = tid >> 6, wm = w >> 1, wn = w & 1, l15 = lane & 15, quad = lane >> 4;
    const int coff = t64 * 64 + wn * 32;
    const size_t base = ((size_t)b * 256) * 1024 + coff;
    resid_epilogue2(acc, (l == 0 ? p.ctx : XC) + base, XC + base, MOD + (size_t)(l * 9 + 8) * 6144 + 2048 + coff, wm, l15, quad);
  }
}

DI void ffnin_epi(const Params& p, const f32x4 (&acc)[4][4], int r0, int tn, unsigned char* lds) {
  unsigned char* act = p.ws + OFF_ACT;
  f32x4 hv[4][2];
#pragma unroll
  for (int mt = 0; mt < 4; ++mt)
#pragma unroll
    for (int np = 0; np < 2; ++np) {
      const f32x4 gte = acc[mt][2 * np], up = acc[mt][2 * np + 1];
#pragma unroll
      for (int i = 0; i < 4; ++i) hv[mt][np][i] = siluf_(gte[i]) * up[i];
    }
  stage_rows<2>(hv, lds, (bf16_t*)(act + F_HID) + (size_t)r0 * 2816 + tn * 64, 2816, 1.0f);
}
DI void ffnin_phase(const Params& p, bool last, unsigned char* lds) {
  unsigned char* act = p.ws + OFF_ACT;
  const int nrt = last ? 64 : 72;
  const int total = nrt * 22, G_ = gridDim.x;
  const int full = (total / G_) * G_;
  for (int i_ = 0; i_ * G_ < full; ++i_) {
    int rt, tp;
    if (!unit_order(i_, nrt, 22, rt, tp)) break;
    const int tm = last ? (rt / 8) * 9 + (rt & 7) : rt;
    const int r0 = tm * 256;
    f32x4 acc0[4][4], acc1[4][4]; zero_acc(acc0); zero_acc(acc1);
    gemm_tile2<true>((const bf16_t*)(act + F_H2) + (size_t)r0 * 1024, 1024, (const bf16_t*)(act + F_WFI) + (size_t)tp * 256 * 1024, 1024, 1024, lds, acc0, acc1);
    ffnin_epi(p, acc0, r0, 2 * tp, lds);
    ffnin_epi(p, acc1, r0, 2 * tp + 1, lds);
  }
  for (int sidx = blockIdx.x; sidx < 2 * (total - full); sidx += G_) {
    int rt, tp;
    if (!unit_of((long)full + (sidx >> 1), nrt, 22, rt, tp)) break;
    const int tm = last ? (rt / 8) * 9 + (rt & 7) : rt;
    const int r0 = tm * 256, tn = 2 * tp + (sidx & 1);
    f32x4 acc[4][4]; zero_acc(acc);
    gemm_tile<true, false>((const bf16_t*)(act + F_H2) + (size_t)r0 * 1024, 1024, (const bf16_t*)(act + F_WFI) + (size_t)tn * 128 * 1024, 1024, 1024, lds, acc);
    ffnin_epi(p, acc, r0, tn, lds);
  }
}

DI void ffnout_epi(const Params& p, const f32x4 (&acc)[4][4], int l, int tm, int tn) {
  const float* MOD = (const float*)(p.ws + OFF_MOD);
  float* XC = (float*)(p.ws + OFF_XC);
  const int tid = opaque_tid(), lane = tid & 63, w = tid >> 6, wm = w >> 1, wn = w & 1, l15 = lane & 15, quad = lane >> 4;
  const int b = tm / 9, tt = tm - b * 9;
  const int coff = tn * 128 + wn * 64;
  if (tt < 8) {
    const size_t base = ((size_t)b * 2048 + tt * 256) * 1024 + coff;
    resid_epilogue(acc, p.out + base, p.out + base, MOD + (size_t)(l * 9 + b) * 6144 + 5120 + coff, wm, l15, quad);
  } else {
    const size_t base = ((size_t)b * 256) * 1024 + coff;
    resid_epilogue(acc, XC + base, XC + base, MOD + (size_t)(l * 9 + 8) * 6144 + 5120 + coff, wm, l15, quad);
  }
}
DI void ffnout_phase(const Params& p, int l, bool last, unsigned char* lds) {
  unsigned char* act = p.ws + OFF_ACT;
  const int nrt = last ? 64 : 72;
  for (int i_ = 0;; ++i_) {
    int rt, tp;
    if (!unit_order(i_, nrt, 4, rt, tp)) break;
    const int tm = last ? (rt / 8) * 9 + (rt & 7) : rt;
    const int r0 = tm * 256;
    f32x4 acc0[4][4], acc1[4][4]; zero_acc(acc0); zero_acc(acc1);
    gemm_tile2<true>((const bf16_t*)(act + F_HID) + (size_t)r0 * 2816, 2816, (const bf16_t*)(act + F_WFO) + (size_t)tp * 256 * 2816, 2816, 2816, lds, acc0, acc1);
    ffnout_epi(p, acc0, l, tm, 2 * tp);
    ffnout_epi(p, acc1, l, tm, 2 * tp + 1);
  }
}

DI void convert_mixer_weights(const Params& p, int l, unsigned char* lds) {
  unsigned char* wm = p.ws + OFF_WM;
  const int tid = opaque_tid(), lane = tid & 63, w = tid >> 6;
  float* wl = (float*)(lds + w * 4352);
  const int total = 13344;
  for (int id = blockIdx.x * 8 + w; id < total; id += gridDim.x * 8) {
    const float* src; int K, N, mode = 0, rem; bf16_t* dst; const float* ks = nullptr;
    if (id < 8160) { src = p.w_in + (size_t)l * 1024 * 8160; K = 1024; N = 8160; dst = (bf16_t*)(wm + WM_WIN); mode = 1; rem = id; }
    else if (id < 8736) { src = p.w_q_up + (size_t)l * 384 * 1536; K = 384; N = 1536; dst = (bf16_t*)(wm + WM_WQU); ks = p.q_norm + l * 384; rem = id - 8160; }
    else if (id < 9248) { src = p.w_kv_up + (size_t)l * 256 * 2048; K = 256; N = 2048; dst = (bf16_t*)(wm + WM_WKVU); ks = p.kv_norm + l * 256; rem = id - 8736; }
    else if (id < 10272) { src = p.w_pa + (size_t)l * 1024 * 1024; K = 1024; N = 1024; dst = (bf16_t*)(wm + WM_WPA); rem = id - 9248; }
    else if (id < 11296) { src = p.w_pb + (size_t)l * 1024 * 1024; K = 1024; N = 1024; dst = (bf16_t*)(wm + WM_WPB); rem = id - 10272; }
    else if (id < 12320) { src = p.w_pc + (size_t)l * 1024 * 1024; K = 1024; N = 1024; dst = (bf16_t*)(wm + WM_WPC); rem = id - 11296; }
    else { src = p.w_o + (size_t)l * 1024 * 1024; K = 1024; N = 1024; dst = (bf16_t*)(wm + WM_WO); rem = id - 12320; }
    convert_wave_tile(src, K, N, dst, mode, ks, rem, wl, lane);
  }
  if (blockIdx.x == 0) { unsigned* z = (unsigned*)(wm + WM_WIN + (size_t)5088 * 1024 * 2); for (int i = tid; i < 32 * 1024 / 2; i += 512) z[i] = 0u; }
  __syncthreads();
}
DI void convert_ffn_weights(const Params& p, int l, unsigned char* lds) {
  unsigned char* act = p.ws + OFF_ACT;
  const int tid = opaque_tid(), lane = tid & 63, w = tid >> 6;
  float* wl = (float*)(lds + w * 4352);
  const int n1 = 16 * 352, total = n1 + 44 * 64;
  for (int id = blockIdx.x * 8 + w; id < total; id += gridDim.x * 8) {
    if (id < n1) convert_wave_tile(p.w_ffn_in + (size_t)l * 1024 * 5632, 1024, 5632, (bf16_t*)(act + F_WFI), 2, nullptr, id, wl, lane);
    else convert_wave_tile(p.w_ffn_out + (size_t)l * 2816 * 1024, 2816, 1024, (bf16_t*)(act + F_WFO), 0, nullptr, id - n1, wl, lane);
  }
  __syncthreads();
}


#define XB_TMO      128
#define XB_XCNT(j)  (256  + 64 * (j))
#define XB_XSUB(j)  (1280 + 64 * (j))
#define XB_XGEN(j)  (2304 + 64 * (j))
#define XB_TOP      3328
#define XB_TOPGEN   3392
#define XCD_BAR_WORDS 3456
#define XB_SPIN_CAP (1u << 18)
DI unsigned xb_ld(unsigned* p)              { return __hip_atomic_load(p, __ATOMIC_RELAXED, __HIP_MEMORY_SCOPE_AGENT); }
DI unsigned xb_add(unsigned* p, unsigned v) { return __hip_atomic_fetch_add(p, v, __ATOMIC_RELAXED, __HIP_MEMORY_SCOPE_AGENT); }
DI unsigned xb_xcc_id() { return (unsigned)__builtin_amdgcn_s_getreg((3 << 11) | 20) & 0xFu; }
#define XB_SPIN(cond, bar) do { unsigned _sp = 0; while (cond) { __builtin_amdgcn_s_sleep(1); \
    if ((++_sp & 255u) == 0u) { if (xb_ld(&(bar)[XB_TMO])) break; if (_sp > XB_SPIN_CAP) { atomicAdd(&(bar)[XB_TMO], 1u); break; } } } } while (0)
struct XcdBarrier { unsigned* bar; unsigned x; volatile LAS unsigned* st; };
DI XcdBarrier xcd_barrier_post(unsigned* bar, volatile LAS unsigned* st) {
  XcdBarrier b; b.bar = bar; b.x = xb_xcc_id(); b.st = st;
  if (threadIdx.x == 0) (void)xb_add(&bar[XB_XCNT(b.x)], 1u);
  return b;
}
DI void xcd_barrier_complete(unsigned* bar, unsigned x, unsigned& nloc, unsigned& nx) {
  const unsigned G = gridDim.x * gridDim.y * gridDim.z;
  unsigned sum, cnt, mine, sp = 0u;
  for (;;) {
    sum = 0u; cnt = 0u; mine = 0u;
#pragma unroll
    for (unsigned j = 0; j < 16; ++j) { const unsigned c = xb_ld(&bar[XB_XCNT(j)]); sum += c; cnt += (c > 0u) ? 1u : 0u; mine = (j == x) ? c : mine; }
    if (sum == G) break;
    __builtin_amdgcn_s_sleep(1);
    if ((++sp & 255u) == 0u) { if (xb_ld(&bar[XB_TMO])) break; if (sp > XB_SPIN_CAP) { atomicAdd(&bar[XB_TMO], 1u); break; } }
  }
  nloc = mine > 0u ? mine : 1u; nx = cnt > 0u ? cnt : 1u;
}
DI void xcd_barrier(const XcdBarrier& b) {
  asm volatile("s_waitcnt vmcnt(0)" ::: "memory");
  __syncthreads();
  if (threadIdx.x == 0) {
    unsigned* bar = b.bar;
    __builtin_amdgcn_s_waitcnt(0);
    unsigned nloc = b.st[0], nx = b.st[1];
    if (nloc == 0u) { xcd_barrier_complete(bar, b.x, nloc, nx); b.st[0] = nloc; b.st[1] = nx; }
    const unsigned old = xb_add(&bar[XB_XSUB(b.x)], 1u);
    const unsigned gen = old / nloc;
    if (old + 1u == (gen + 1u) * nloc) {
      __builtin_amdgcn_fence(__ATOMIC_RELEASE, "agent");
      asm volatile("s_waitcnt vmcnt(0)" ::: "memory");
      const unsigned og = xb_add(&bar[XB_TOP], 1u);
      const unsigned tg = og / nx;
      if (og + 1u == (tg + 1u) * nx) xb_add(&bar[XB_TOPGEN], 1u);
      else XB_SPIN(xb_ld(&bar[XB_TOPGEN]) == tg, bar);
      __builtin_amdgcn_fence(__ATOMIC_ACQUIRE, "agent");
      xb_add(&bar[XB_XGEN(b.x)], 1u);
      asm volatile("s_waitcnt vmcnt(0)" ::: "memory");
    } else {
      XB_SPIN(xb_ld(&bar[XB_XGEN(b.x)]) == gen, bar);
      __builtin_amdgcn_fence(__ATOMIC_ACQUIRE, "agent");
      asm volatile("s_waitcnt vmcnt(0)" ::: "memory");
    }
  }
  __syncthreads();
}

DI void grid_barrier(unsigned* ctr, unsigned& phase) {
  asm volatile("s_waitcnt vmcnt(0)" ::: "memory");
  __syncthreads();
  phase += 1u;
  if (threadIdx.x == 0) {
    __builtin_amdgcn_fence(__ATOMIC_RELEASE, "agent");
    asm volatile("s_waitcnt vmcnt(0)" ::: "memory");
    __hip_atomic_fetch_add(ctr, 1u, __ATOMIC_RELAXED, __HIP_MEMORY_SCOPE_AGENT);
    const unsigned target = phase * gridDim.x;
    unsigned spins = 0;
    while (__hip_atomic_load(ctr, __ATOMIC_RELAXED, __HIP_MEMORY_SCOPE_AGENT) < target) { __builtin_amdgcn_s_sleep(1); if (++spins > (1u << 24)) break; }
    __builtin_amdgcn_fence(__ATOMIC_ACQUIRE, "agent");
    asm volatile("s_waitcnt vmcnt(0)" ::: "memory");
  }
  __syncthreads();
}

__global__ void __launch_bounds__(512) fwd_megakernel(Params p) {
  cg::grid_group grid = cg::this_grid();
  unsigned char* lds = dyn_lds;
  unsigned char* act = p.ws + OFF_ACT;
  unsigned* gbar = (unsigned*)(p.ws + OFF_CTR) + 128;
  unsigned bphase = 0u;
  if (blockIdx.x == 0) { const int t0 = opaque_tid(); if (t0 < 256) ((unsigned*)(p.ws + OFF_CTR))[t0] = 0u;
    for (int i = t0; i < XCD_BAR_WORDS; i += 512) ((unsigned*)(p.ws + OFF_XBAR))[i] = 0u; }
  volatile LAS unsigned* xb_st = (volatile LAS unsigned*)((LAS unsigned char*)dyn_lds + (LDS_BYTES - 32));
  if (threadIdx.x == 0) { xb_st[0] = 0u; xb_st[1] = 0u; }
  grid.sync();
  const XcdBarrier xbar = xcd_barrier_post((unsigned*)(p.ws + OFF_XBAR), xb_st);
  {
    const int tid = opaque_tid(), lane = tid & 63, w = tid >> 6;
    float* sc = (float*)lds;
    float* red = (float*)(lds + 36864);
    float* MOD = (float*)(p.ws + OFF_MOD);
    for (int item = blockIdx.x; item < 192; item += gridDim.x) {
      for (int i = tid; i < 9216; i += 512) { const int b = i >> 10, k = i & 1023; const float v = b < 8 ? p.c[b * 1024 + k] : p.c_ctx[k]; sc[i] = siluf_(v); }
      __syncthreads();
      const int l = item / 96, cb = (item % 96) * 64;
      float a[9];
#pragma unroll
      for (int b = 0; b < 9; ++b) a[b] = 0.f;
      const float* wp = p.w_mod + ((size_t)l * 1024 + w * 128) * 6144 + cb + lane;
#pragma unroll 8
      for (int k = 0; k < 128; ++k) {
        const float wv = wp[(size_t)k * 6144];
#pragma unroll
        for (int b = 0; b < 9; ++b) a[b] += sc[b * 1024 + w * 128 + k] * wv;
      }
#pragma unroll
      for (int b = 0; b < 9; ++b) red[(w * 9 + b) * 64 + lane] = a[b];
      __syncthreads();
      for (int i = tid; i < 576; i += 512) {
        const int b = i >> 6, ln = i & 63;
        float s = 0.f;
        for (int ww = 0; ww < 8; ++ww) s += red[(ww * 9 + b) * 64 + ln];
        MOD[(size_t)(l * 9 + b) * 6144 + cb + ln] = s + p.b_mod[l * 6144 + cb + ln];
      }
      __syncthreads();
    }
    if (blockIdx.x == gridDim.x - 1) {
      float2* rope = (float2*)(p.ws + OFF_ROPE);
      for (int i = tid; i < 1024; i += 512) {
        const int pos = i >> 4, f = i & 15;
        const float inv = powf(10000.0f, -(float)f / 16.0f);
        const float ang = (float)pos * inv;
        rope[i] = make_float2(cosf(ang), sinf(ang));
      }
    }
  }
  for (int l_ = 0; l_ < 2; ++l_) {
    int l = l_; asm volatile("" : "+s"(l));
    const bool last = (l == 1);
    convert_mixer_weights(p, l, lds);
    xcd_barrier(xbar);
    for (int g = 0; g < NGRP; ++g) {
      if (g == 0) {
        { float* rsq = (float*)(p.ws + OFF_RSQ); for (int i = blockIdx.x * 512 + opaque_tid(); i < 2 * R; i += gridDim.x * 512) rsq[i] = 0.f; }
        norm_phase(p, l, 0, 0, BG, l == 0 ? p.x : p.out, l == 0 ? p.ctx : (const float*)(p.ws + OFF_XC), (bf16_t*)(act + A_H), false);
        xcd_barrier(xbar);
      }
      inproj_phase(p, g, lds);
      xcd_barrier(xbar);
      mlaup_phase(p, last, lds);
      xcd_barrier(xbar);
      mixers_phase(p, l, g, last, lds);
      xcd_barrier(xbar);
      glapost_phase(p, l);
      xcd_barrier(xbar);
      merge_phase(p, last, lds);
      xcd_barrier(xbar);
      wo_phase(p, l, g, last, lds);
      if (g == 0) {
        { float* rsq = (float*)(p.ws + OFF_RSQ); for (int i = blockIdx.x * 512 + opaque_tid(); i < 2 * R; i += gridDim.x * 512) rsq[i] = 0.f; }
        norm_phase(p, l, 0, BG, BG, l == 0 ? p.x : p.out, l == 0 ? p.ctx : (const float*)(p.ws + OFF_XC), (bf16_t*)(act + A_H), false);
      }
      xcd_barrier(xbar);
    }
    {
      convert_ffn_weights(p, l, lds);
      norm_phase(p, l, 1, 0, 8, p.out, (const float*)(p.ws + OFF_XC), (bf16_t*)(act + F_H2), last);
    }
    xcd_barrier(xbar);
    ffnin_phase(p, last, lds);
    xcd_barrier(xbar);
    ffnout_phase(p, l, last, lds);
    xcd_barrier(xbar);
  }
  const int tid = opaque_tid(), lane = tid & 63, w = tid >> 6;
  for (int r = blockIdx.x * 8 + w; r < 16384; r += gridDim.x * 8) {
    float* xp = p.out + (size_t)r * 1024;
    float4 v[4]; float ss = 0.f;
#pragma unroll
    for (int i = 0; i < 4; ++i) { v[i] = *(const float4*)(xp + lane * 4 + 256 * i); ss += v[i].x * v[i].x + v[i].y * v[i].y + v[i].z * v[i].z + v[i].w * v[i].w; }
#pragma unroll
    for (int o = 32; o >= 1; o >>= 1) ss += shx(ss, lane, o);
    const float rstd = rsqrtf(ss * (1.0f / 1024.0f) + 1e-6f);
#pragma unroll
    for (int i = 0; i < 4; ++i) {
      const float4 gn = *(const float4*)(p.final_norm + lane * 4 + 256 * i);
      float4 o; o.x = v[i].x * rstd * gn.x; o.y = v[i].y * rstd * gn.y; o.z = v[i].z * rstd * gn.z; o.w = v[i].w * rstd * gn.w;
      *(float4*)(xp + lane * 4 + 256 * i) = o;
    }
  }
}

extern "C" void kernel_launch(void* const* d_in, const int* in_sizes, int n_in, void* d_out, int out_size, void* d_ws, size_t ws_size,
                              hipStream_t stream) {
  constexpr size_t kDynLds = LDS_BYTES;
  static int grid_blocks = 0;
  if (!grid_blocks) {
    int dev = 0, cus = 0, per_cu = 0;
    hipGetDevice(&dev);
    hipDeviceGetAttribute(&cus, hipDeviceAttributeMultiprocessorCount, dev);
    hipFuncSetAttribute((const void*)fwd_megakernel, hipFuncAttributeMaxDynamicSharedMemorySize, (int)kDynLds);
    hipOccupancyMaxActiveBlocksPerMultiprocessor(&per_cu, fwd_megakernel, 512, kDynLds);
    if (per_cu < 1) per_cu = 1;
    if (per_cu > 1) per_cu = 1;
    grid_blocks = cus * per_cu;
  }
  if (ws_size < WS_NEED) { fprintf(stderr, "workspace too small: %zu < %zu\n", ws_size, (size_t)WS_NEED); }
  Params p{};
  const float** pp = (const float**)&p;
  for (int i = 0; i < 26; ++i) pp[i] = (const float*)d_in[i];
  p.out = (float*)d_out;
  p.ws = (unsigned char*)d_ws;
  void* args[] = {&p};
  hipError_t e = hipLaunchCooperativeKernel((void*)fwd_megakernel, dim3(grid_blocks), dim3(512), args, kDynLds, stream);
  if (e != hipSuccess) fprintf(stderr, "cooperative launch failed: %s (grid %d)\n", hipGetErrorString(e), grid_blocks);
}
```

```cpp
#include <hip/hip_runtime.h>
#include <hip/hip_cooperative_groups.h>
#include <cstdio>
#include <cstdint>
namespace cg = cooperative_groups;
#define DI __device__ __forceinline__
typedef unsigned short bf16_t;
typedef short bf16x8 __attribute__((ext_vector_type(8)));
typedef short s16x4 __attribute__((ext_vector_type(4)));
typedef float f32x4 __attribute__((ext_vector_type(4)));
typedef unsigned u32x2 __attribute__((ext_vector_type(2)));
typedef unsigned u32x4 __attribute__((ext_vector_type(4)));

constexpr int TT = 2304;
constexpr int BG = 4;
constexpr int NGRP = 2;
constexpr int R = BG * TT;
constexpr int RALL = 8 * TT;
constexpr float LOG2E = 1.4426950408889634f;

constexpr size_t OFF_CTR = 0;
constexpr size_t OFF_MOD = 4096;
constexpr size_t OFF_ROPE = OFF_MOD + 2 * 9 * 6144 * 4;
constexpr size_t OFF_RSQ = OFF_ROPE + 64 * 16 * 8;
constexpr size_t OFF_XBAR = OFF_RSQ + (size_t)2 * R * 4;
constexpr size_t OFF_XC = OFF_XBAR + 16384;
constexpr size_t OFF_WM = OFF_XC + (size_t)2048 * 1024 * 4;
constexpr size_t WM_WIN = 0;
constexpr size_t WM_WQU = WM_WIN + (size_t)8192 * 1024 * 2;
constexpr size_t WM_WKVU = WM_WQU + (size_t)1536 * 384 * 2;
constexpr size_t WM_WPA = WM_WKVU + (size_t)2048 * 256 * 2;
constexpr size_t WM_WPB = WM_WPA + (size_t)1024 * 1024 * 2;
constexpr size_t WM_WPC = WM_WPB + (size_t)1024 * 1024 * 2;
constexpr size_t WM_WO = WM_WPC + (size_t)1024 * 1024 * 2;
constexpr size_t WM_SIZE = WM_WO + (size_t)1024 * 1024 * 2;
constexpr size_t OFF_ACT = OFF_WM + WM_SIZE;
constexpr size_t A_H = 0;
constexpr size_t A_GQK = A_H + (size_t)R * 2048;
constexpr size_t A_GVT = A_GQK + (size_t)R * 2048;
constexpr size_t A_GG = A_GVT + (size_t)R * 2048;
constexpr size_t A_GKR = A_GG + (size_t)R * 2048;
constexpr size_t A_SQ = A_GKR + (size_t)R * 128;
constexpr size_t A_SK = A_SQ + (size_t)R * 2048;
constexpr size_t A_SVT = A_SK + (size_t)R * 256;
constexpr size_t A_CQ = A_SVT + (size_t)R * 256;
constexpr size_t A_CKV = A_CQ + (size_t)R * 768;
constexpr size_t A_KR = A_CKV + (size_t)R * 512;
constexpr size_t A_QF = A_KR + (size_t)R * 128;
constexpr size_t A_KN = A_QF + (size_t)R * 3072;
constexpr size_t A_VT = A_KN + (size_t)R * 2048;
constexpr size_t A_MG = A_VT + (size_t)R * 2048;
constexpr size_t A_OB = A_MG + (size_t)R * 6144;
constexpr size_t ACT_SIZE = A_OB + (size_t)R * 2048;
constexpr size_t F_H2 = 0;
constexpr size_t F_HID = F_H2 + (size_t)RALL * 2048;
constexpr size_t F_WFI = F_HID + (size_t)RALL * 5632;
constexpr size_t F_WFO = F_WFI + (size_t)5632 * 1024 * 2;
constexpr size_t WS_NEED = OFF_ACT + ACT_SIZE;

constexpr int LDS_BYTES = 151552;
constexpr int G_BUF = 49152, G_BOFF = 32768, G_EXTRA = 147456;
constexpr int L_QD = 0, L_KI = L_QD + 17408, L_KET = L_KI + 17408, L_VT = L_KET + 18432, L_ST = L_VT + 9216,
              L_WG = L_ST + 17408, L_BG = L_WG + 8192, L_ETOT = L_BG + 512, L_END = L_ETOT + 512;
constexpr int L_ITEM = LDS_BYTES - 16;
static_assert(L_END <= L_ITEM, "lds");

struct Params {
  const float *x, *c, *ctx, *c_ctx, *w_mod, *b_mod, *norm_mix, *w_in, *w_gk_fwd, *b_gk_fwd, *w_gk_bwd, *b_gk_bwd, *gla_norm, *sinks,
      *q_norm, *w_q_up, *kv_norm, *w_kv_up, *w_pa, *w_pb, *w_pc, *w_o, *norm_ffn, *w_ffn_in, *w_ffn_out, *final_norm;
  float* out;
  unsigned char* ws;
};

extern __shared__ __attribute__((aligned(16))) unsigned char dyn_lds[];

typedef __bf16 bf16x2_t __attribute__((ext_vector_type(2)));
typedef float f32x2_t __attribute__((ext_vector_type(2)));
DI unsigned pk2(float lo, float hi) { f32x2_t f = {lo, hi}; bf16x2_t v = __builtin_convertvector(f, bf16x2_t); return __builtin_bit_cast(unsigned, v); }
DI float bflo(unsigned w) { return __uint_as_float(w << 16); }
DI float bfhi(unsigned w) { return __uint_as_float(w & 0xffff0000u); }
DI float bf2f(bf16_t v) { return __uint_as_float(((unsigned)v) << 16); }
DI bf16_t f2bf(float x) { return (bf16_t)(pk2(x, 0.f) & 0xffffu); }
DI u32x2 pk4(f32x4 v) { u32x2 r; r.x = pk2(v[0], v[1]); r.y = pk2(v[2], v[3]); return r; }
DI float sigmoidf_(float x) { return __builtin_amdgcn_rcpf(1.0f + __builtin_amdgcn_exp2f(-1.4426950408889634f * x)); }
DI float siluf_(float x) { return x * __builtin_amdgcn_rcpf(1.0f + __builtin_amdgcn_exp2f(-1.4426950408889634f * x)); }
DI int opaque_tid() { int t = threadIdx.x; asm volatile("" : "+v"(t)); return t; }

template <int CTRL, int ROWMASK, bool BOUND>
DI float dpp_move(float x) { return __builtin_bit_cast(float, __builtin_amdgcn_update_dpp(0, __builtin_bit_cast(int, x), CTRL, ROWMASK, 0xF, BOUND)); }
DI float wave_incl_scan(float x) {
  x += dpp_move<0x111, 0xF, true>(x);
  x += dpp_move<0x112, 0xF, true>(x);
  x += dpp_move<0x114, 0xF, true>(x);
  x += dpp_move<0x118, 0xF, true>(x);
  x += dpp_move<0x142, 0xA, false>(x);
  x += dpp_move<0x143, 0xC, false>(x);
  return x;
}
DI float shx(float v, int lane, int m) { return __builtin_bit_cast(float, __builtin_amdgcn_ds_bpermute((lane ^ m) << 2, __builtin_bit_cast(int, v))); }
#define LDS_BARRIER() do { asm volatile("s_waitcnt lgkmcnt(0)" ::: "memory"); __builtin_amdgcn_s_barrier(); asm volatile("" ::: "memory"); } while (0)
#define MFMA16(a, b, c) __builtin_amdgcn_mfma_f32_16x16x32_bf16((a), (b), (c), 0, 0, 0)

#define LAS __attribute__((address_space(3)))
template <bool SWAP, bool ASEG, bool DEEP = true>
DI void gemm_tile(const bf16_t* __restrict__ A, int lda, const bf16_t* __restrict__ Bt, int ldb, int K, unsigned char* lds,
                  f32x4 (&acc)[4][4]) {
  const int tid = opaque_tid(), lane = tid & 63, w = tid >> 6, wm = w >> 1, wn = w & 1, l15 = lane & 15, quad = lane >> 4;
  const int lrow = tid >> 3;
  const int lchs = (tid & 7) ^ ((lrow >> 1) & 7);
  const int nk = K >> 6;
  const unsigned voffA = (unsigned)(lrow * lda + lchs * 8) * 2u, voffB = (unsigned)(lrow * ldb + lchs * 8) * 2u;
  const char* Ab = (const char*)A; const char* Bb = (const char*)Bt;
  LAS unsigned char* l3 = (LAS unsigned char*)dyn_lds;
  const int sw0 = ((quad ^ (l15 >> 1)) * 16), sw1 = (((4 + quad) ^ (l15 >> 1)) * 16);
  const int arow = (wm * 64 + l15) * 128, brow = G_BOFF + (wn * 64 + l15) * 128;
#define GT_DMA(KT, ST) do { const int ku_ = ASEG ? (((KT) >> 1) * 192 + ((KT) & 1) * 64) : (KT) * 64; \
    _Pragma("unroll") for (int i = 0; i < 4; ++i) __builtin_amdgcn_global_load_lds((const unsigned*)(Ab + (size_t)(64 * i * lda + ku_) * 2 + voffA), \
        (LAS unsigned*)(l3 + (ST) * G_BUF + i * 8192 + w * 1024), 16, 0, 0); \
    _Pragma("unroll") for (int i = 0; i < 2; ++i) __builtin_amdgcn_global_load_lds((const unsigned*)(Bb + (size_t)(64 * i * ldb + (KT) * 64) * 2 + voffB), \
        (LAS unsigned*)(l3 + (ST) * G_BUF + G_BOFF + i * 8192 + w * 1024), 16, 0, 0); } while (0)
#define GT_READ(AF, BF, ST, KS) do { const unsigned char* base_ = lds + (ST) * G_BUF + ((KS) ? sw1 : sw0); \
    _Pragma("unroll") for (int mt = 0; mt < 4; ++mt) AF[mt] = *(const bf16x8*)(base_ + arow + mt * 16 * 128); \
    _Pragma("unroll") for (int nt = 0; nt < 4; ++nt) BF[nt] = *(const bf16x8*)(base_ + brow + nt * 16 * 128); } while (0)
#define GT_MMA(AF, BF) do { _Pragma("unroll") for (int mt = 0; mt < 4; ++mt) _Pragma("unroll") for (int nt = 0; nt < 4; ++nt) \
      acc[mt][nt] = SWAP ? MFMA16(BF[nt], AF[mt], acc[mt][nt]) : MFMA16(AF[mt], BF[nt], acc[mt][nt]); } while (0)
  bf16x8 fa0[4], fb0[4], fa1[4], fb1[4];
  GT_DMA(0, 0);
  GT_DMA(1, 1);
  asm volatile("s_waitcnt vmcnt(6)" ::: "memory");
  LDS_BARRIER();
  int st = 0;
  for (int kt = 0; kt < nk; ++kt) {
    const bool more2 = (kt + 2 < nk);
    if (more2) { const int s2 = st == 0 ? 2 : st - 1; GT_DMA(kt + 2, s2); }
    GT_READ(fa0, fb0, st, 0);
    GT_READ(fa1, fb1, st, 1);
    GT_MMA(fa0, fb0);
    GT_MMA(fa1, fb1);
    if (more2) asm volatile("s_waitcnt vmcnt(6)" ::: "memory"); else asm volatile("s_waitcnt vmcnt(0)" ::: "memory");
    LDS_BARRIER();
    st = st == 2 ? 0 : st + 1;
  }
#undef GT_DMA
#undef GT_READ
#undef GT_MMA
}
template <bool ASEG>
DI void gemm_tile_n64(const bf16_t* __restrict__ A, int lda, const bf16_t* __restrict__ Bt, int ldb, int K, unsigned char* lds,
                      f32x4 (&acc)[4][2]) {
  const int tid = opaque_tid(), lane = tid & 63, w = tid >> 6, wm = w >> 1, wn = w & 1, l15 = lane & 15, quad = lane >> 4;
  const int lrow = tid >> 3;
  const int lchs = (tid & 7) ^ ((lrow >> 1) & 7);
  const int nk = K >> 6;
  const unsigned voffA = (unsigned)(lrow * lda + lchs * 8) * 2u, voffB = (unsigned)(lrow * ldb + lchs * 8) * 2u;
  const char* Ab = (const char*)A; const char* Bb = (const char*)Bt;
  LAS unsigned char* l3 = (LAS unsigned char*)dyn_lds;
  const int sw0 = ((quad ^ (l15 >> 1)) * 16), sw1 = (((4 + quad) ^ (l15 >> 1)) * 16);
  const int arow = (wm * 64 + l15) * 128, brow = G_BOFF + (wn * 32 + l15) * 128;
#define GN_DMA(KT, ST) do { const int ku_ = ASEG ? (((KT) >> 1) * 192 + ((KT) & 1) * 64) : (KT) * 64; \
    _Pragma("unroll") for (int i = 0; i < 4; ++i) __builtin_amdgcn_global_load_lds((const unsigned*)(Ab + (size_t)(64 * i * lda + ku_) * 2 + voffA), \
        (LAS unsigned*)(l3 + (ST) * G_BUF + i * 8192 + w * 1024), 16, 0, 0); \
    __builtin_amdgcn_global_load_lds((const unsigned*)(Bb + (size_t)((KT) * 64) * 2 + voffB), (LAS unsigned*)(l3 + (ST) * G_BUF + G_BOFF + w * 1024), 16, 0, 0); } while (0)
  GN_DMA(0, 0);
  GN_DMA(1, 1);
  asm volatile("s_waitcnt vmcnt(5)" ::: "memory");
  LDS_BARRIER();
  int st = 0;
  for (int kt = 0; kt < nk; ++kt) {
    const bool more2 = (kt + 2 < nk);
    if (more2) { const int s2 = st == 0 ? 2 : st - 1; GN_DMA(kt + 2, s2); }
#pragma unroll
    for (int ks = 0; ks < 2; ++ks) {
      const unsigned char* base_ = lds + st * G_BUF + (ks ? sw1 : sw0);
      bf16x8 fa[4], fb[2];
#pragma unroll
      for (int mt = 0; mt < 4; ++mt) fa[mt] = *(const bf16x8*)(base_ + arow + mt * 16 * 128);
#pragma unroll
      for (int nt = 0; nt < 2; ++nt) fb[nt] = *(const bf16x8*)(base_ + brow + nt * 16 * 128);
#pragma unroll
      for (int mt = 0; mt < 4; ++mt)
#pragma unroll
        for (int nt = 0; nt < 2; ++nt) acc[mt][nt] = MFMA16(fb[nt], fa[mt], acc[mt][nt]);
    }
    if (more2) asm volatile("s_waitcnt vmcnt(5)" ::: "memory"); else asm volatile("s_waitcnt vmcnt(0)" ::: "memory");
    LDS_BARRIER();
    st = st == 2 ? 0 : st + 1;
  }
#undef GN_DMA
}
DI void zero_acc(f32x4 (&acc)[4][4]) {
#pragma unroll
  for (int a = 0; a < 4; ++a)
#pragma unroll
    for (int b = 0; b < 4; ++b) acc[a][b] = (f32x4){0.f, 0.f, 0.f, 0.f};
}

template <bool SWAP>
DI void gemm_tile2(const bf16_t* __restrict__ A, int lda, const bf16_t* __restrict__ Bt, int ldb, int K, unsigned char* lds,
                   f32x4 (&acc0)[4][4], f32x4 (&acc1)[4][4]) {
  const int tid = opaque_tid(), lane = tid & 63, w = tid >> 6, wm = w >> 1, wn = w & 1, l15 = lane & 15, quad = lane >> 4;
  const int lrow = tid >> 3;
  const int lchs = (tid & 7) ^ ((lrow >> 1) & 7);
  const int nk = K >> 6;
  const unsigned voffA = (unsigned)(lrow * lda + lchs * 8) * 2u, voffB = (unsigned)(lrow * ldb + lchs * 8) * 2u;
  const char* Ab = (const char*)A; const char* Bb = (const char*)Bt;
  LAS unsigned char* l3 = (LAS unsigned char*)dyn_lds;
  const int sw0 = ((quad ^ (l15 >> 1)) * 16), sw1 = (((4 + quad) ^ (l15 >> 1)) * 16);
  const int arow = (wm * 64 + l15) * 128, brow = 32768 + (wn * 64 + l15) * 128;
  constexpr int SB = 65536;
#define G2_DMA(KT, ST) do { \
    _Pragma("unroll") for (int i = 0; i < 4; ++i) __builtin_amdgcn_global_load_lds((const unsigned*)(Ab + (size_t)(64 * i * lda + (KT) * 64) * 2 + voffA), \
        (LAS unsigned*)(l3 + (ST) * SB + i * 8192 + w * 1024), 16, 0, 0); \
    _Pragma("unroll") for (int i = 0; i < 4; ++i) __builtin_amdgcn_global_load_lds((const unsigned*)(Bb + (size_t)(64 * i * ldb + (KT) * 64) * 2 + voffB), \
        (LAS unsigned*)(l3 + (ST) * SB + 32768 + i * 8192 + w * 1024), 16, 0, 0); } while (0)
  G2_DMA(0, 0);
  asm volatile("s_waitcnt vmcnt(0)" ::: "memory");
  LDS_BARRIER();
  for (int kt = 0; kt < nk; ++kt) {
    const int st = kt & 1;
    if (kt + 1 < nk) G2_DMA(kt + 1, st ^ 1);
#pragma unroll
    for (int ks = 0; ks < 2; ++ks) {
      const unsigned char* base_ = lds + st * SB + (ks ? sw1 : sw0);
      bf16x8 fa[4], fb0[4], fb1[4];
#pragma unroll
      for (int mt = 0; mt < 4; ++mt) fa[mt] = *(const bf16x8*)(base_ + arow + mt * 16 * 128);
#pragma unroll
      for (int nt = 0; nt < 4; ++nt) fb0[nt] = *(const bf16x8*)(base_ + brow + nt * 16 * 128);
#pragma unroll
      for (int nt = 0; nt < 4; ++nt) fb1[nt] = *(const bf16x8*)(base_ + brow + 128 * 128 + nt * 16 * 128);
#pragma unroll
      for (int mt = 0; mt < 4; ++mt)
#pragma unroll
        for (int nt = 0; nt < 4; ++nt) acc0[mt][nt] = SWAP ? MFMA16(fb0[nt], fa[mt], acc0[mt][nt]) : MFMA16(fa[mt], fb0[nt], acc0[mt][nt]);
#pragma unroll
      for (int mt = 0; mt < 4; ++mt)
#pragma unroll
        for (int nt = 0; nt < 4; ++nt) acc1[mt][nt] = SWAP ? MFMA16(fb1[nt], fa[mt], acc1[mt][nt]) : MFMA16(fa[mt], fb1[nt], acc1[mt][nt]);
    }
    asm volatile("s_waitcnt vmcnt(0)" ::: "memory");
    LDS_BARRIER();
  }
#undef G2_DMA
}


DI bool unit_of(long L, int nM, int nN, int& pm, int& pn);
DI bool unit_order(int i, int nM, int nN, int& pm, int& pn) { return unit_of((long)i * gridDim.x + blockIdx.x, nM, nN, pm, pn); }
DI bool unit_of(long L, int nM, int nN, int& pm, int& pn) {
  const int nwg = nM * nN;
  if (L >= nwg) return false;
  int wgid = (int)L;
  { const int q = nwg / 8, r = nwg % 8, xcd = wgid % 8, off = wgid / 8; wgid = (xcd < r ? xcd * (q + 1) : r * (q + 1) + (xcd - r) * q) + off; }
  const int nig = 8 * nN, gid = wgid / nig, fm = gid * 8, gsz = (nM - fm) < 8 ? (nM - fm) : 8;
  pm = fm + ((wgid % nig) % gsz); pn = (wgid % nig) / gsz;
  return true;
}

DI int colmap(int mode, int n) {
  if (mode == 1) { if (n < 3072) return n; if (n < 3104) return n + 1984; if (n < 5088) return n - 32; return n + 32; }
  if (mode == 2) { if (n < 2816) return (n >> 4) * 32 + (n & 15); const int j = n - 2816; return (j >> 4) * 32 + 16 + (j & 15); }
  return n;
}
DI void convert_wave_tile(const float* __restrict__ src, int K, int N, bf16_t* __restrict__ dst, int mode, const float* __restrict__ kscale,
                          int tile, float* wl, int lane) {
  const int ntn = N >> 4;
  const int tk = tile / ntn, tn = tile - tk * ntn;
  const int k0 = tk * 64, n0 = tn * 16;
  const float* sp = src + (size_t)(k0 + lane) * N + n0;
  const float4 v0 = *(const float4*)(sp), v1 = *(const float4*)(sp + 4), v2 = *(const float4*)(sp + 8), v3 = *(const float4*)(sp + 12);
  const float sc = kscale ? kscale[k0 + lane] : 1.0f;
  float* wr = wl + lane * 17;
  wr[0] = v0.x * sc; wr[1] = v0.y * sc; wr[2] = v0.z * sc; wr[3] = v0.w * sc; wr[4] = v1.x * sc; wr[5] = v1.y * sc; wr[6] = v1.z * sc; wr[7] = v1.w * sc;
  wr[8] = v2.x * sc; wr[9] = v2.y * sc; wr[10] = v2.z * sc; wr[11] = v2.w * sc; wr[12] = v3.x * sc; wr[13] = v3.y * sc; wr[14] = v3.z * sc; wr[15] = v3.w * sc;
  __builtin_amdgcn_fence(__ATOMIC_RELEASE, "wavefront");
  __builtin_amdgcn_wave_barrier();
  __builtin_amdgcn_fence(__ATOMIC_ACQUIRE, "wavefront");
  const int n = lane >> 2, kq = (lane & 3) * 16;
  const int np = colmap(mode, n0 + n);
  u32x4 o0, o1;
#pragma unroll
  for (int j = 0; j < 4; ++j) { o0[j] = pk2(wl[(kq + 2 * j) * 17 + n], wl[(kq + 2 * j + 1) * 17 + n]); o1[j] = pk2(wl[(kq + 8 + 2 * j) * 17 + n], wl[(kq + 9 + 2 * j) * 17 + n]); }
  bf16_t* dp = dst + (size_t)np * K + k0 + kq;
  *(u32x4*)(dp) = o0; *(u32x4*)(dp + 8) = o1;
  __builtin_amdgcn_fence(__ATOMIC_RELEASE, "wavefront");
  __builtin_amdgcn_wave_barrier();
  __builtin_amdgcn_fence(__ATOMIC_ACQUIRE, "wavefront");
}

DI void norm_phase(const Params& p, int l, int which, int b0, int nb, const float* xsrc, const float* csrc, bf16_t* H, bool skipctx) {
  const int tid = opaque_tid(), lane = tid & 63, w = tid >> 6;
  const float* MOD = (const float*)(p.ws + OFF_MOD);
  const float* gain = (which ? p.norm_ffn : p.norm_mix) + l * 1024;
  const int rows = nb * TT;
  for (int r = blockIdx.x * 8 + w; r < rows; r += gridDim.x * 8) {
    const int bl = r / TT, t = r - bl * TT, b = b0 + bl;
    if (t >= 2048 && skipctx) continue;
    const float* src = (t < 2048) ? xsrc + ((size_t)b * 2048 + t) * 1024 : csrc + ((size_t)b * 256 + (t - 2048)) * 1024;
    const float* mrow = MOD + (size_t)(l * 9 + (t < 2048 ? b : 8)) * 6144 + which * 3072;
    float4 v[4]; float ss = 0.f;
#pragma unroll
    for (int i = 0; i < 4; ++i) { v[i] = *(const float4*)(src + lane * 4 + 256 * i); ss += v[i].x * v[i].x + v[i].y * v[i].y + v[i].z * v[i].z + v[i].w * v[i].w; }
#pragma unroll
    for (int o = 32; o >= 1; o >>= 1) ss += shx(ss, lane, o);
    const float rstd = rsqrtf(ss * (1.0f / 1024.0f) + 1e-6f);
#pragma unroll
    for (int i = 0; i < 4; ++i) {
      const int col = lane * 4 + 256 * i;
      const float4 g = *(const float4*)(gain + col), sh = *(const float4*)(mrow + col), sc = *(const float4*)(mrow + 1024 + col);
      f32x4 o;
      o[0] = v[i].x * rstd * g.x * (1.f + sc.x) + sh.x; o[1] = v[i].y * rstd * g.y * (1.f + sc.y) + sh.y;
      o[2] = v[i].z * rstd * g.z * (1.f + sc.z) + sh.z; o[3] = v[i].w * rstd * g.w * (1.f + sc.w) + sh.w;
      *(u32x2*)(H + (size_t)r * 1024 + col) = pk4(o);
    }
  }
}

DI void rope_acc(f32x4 (&acc)[4][4], const float2* __restrict__ rope, int t0  , int l15, int quad) {
#pragma unroll
  for (int mt = 0; mt < 4; ++mt) {
    const int t = t0 + mt * 16 + l15;
    const int prow = t >> 6, pcol = t & 63;
    const float4* rpr = (const float4*)(rope + prow * 16 + quad * 4);
    const float4* rpc = (const float4*)(rope + pcol * 16 + quad * 4);
    const float4 r01 = rpr[0], r23 = rpr[1], c01 = rpc[0], c23 = rpc[1];
#pragma unroll
    for (int i = 0; i < 4; ++i) {
      const float2 cr = i == 0 ? make_float2(r01.x, r01.y) : i == 1 ? make_float2(r01.z, r01.w) : i == 2 ? make_float2(r23.x, r23.y) : make_float2(r23.z, r23.w);
      const float2 cc = i == 0 ? make_float2(c01.x, c01.y) : i == 1 ? make_float2(c01.z, c01.w) : i == 2 ? make_float2(c23.x, c23.y) : make_float2(c23.z, c23.w);
      const float a1 = acc[mt][0][i], a2 = acc[mt][1][i];
      acc[mt][0][i] = a1 * cr.x - a2 * cr.y; acc[mt][1][i] = a2 * cr.x + a1 * cr.y;
      const float b1 = acc[mt][2][i], b2 = acc[mt][3][i];
      acc[mt][2][i] = b1 * cc.x - b2 * cc.y; acc[mt][3][i] = b2 * cc.x + b1 * cc.y;
    }
    asm volatile("" ::: "memory");
  }
}
DI void store_rows_direct(const f32x4 (&acc)[4][4], bf16_t* dst, int ld, int wm, int l15, int quad, float scale) {
#pragma unroll
  for (int mt = 0; mt < 4; ++mt) {
    bf16_t* rp = dst + (size_t)(wm * 64 + mt * 16 + l15) * ld + quad * 4;
#pragma unroll
    for (int nt = 0; nt < 4; ++nt) *(u32x2*)(rp + nt * 16) = pk4(acc[mt][nt] * scale);
  }
}
template <int NT>
DI void stage_rows(const f32x4 (&v)[4][NT], unsigned char* lds, bf16_t* dst, int ld, float scale) {
  const int tid = opaque_tid(), lane = tid & 63, w = tid >> 6, wm = w >> 1, wn = w & 1, l15 = lane & 15, quad = lane >> 4;
  constexpr int NC = NT * 32, RS = (NC + 8) * 2, CH = NC / 8, PER = (256 * CH) / 512;
#pragma unroll
  for (int mt = 0; mt < 4; ++mt)
#pragma unroll
    for (int nt = 0; nt < NT; ++nt)
      *(u32x2*)(lds + (wm * 64 + mt * 16 + l15) * RS + (wn * NT * 16 + nt * 16 + quad * 4) * 2) = pk4(v[mt][nt] * scale);
  LDS_BARRIER();
#pragma unroll
  for (int i = 0; i < PER; ++i) {
    const int id = tid + 512 * i, row = id / CH, ch = id % CH;
    const u32x4 x = *(const u32x4*)(lds + row * RS + ch * 16);
    *(u32x4*)(dst + (size_t)row * ld + ch * 8) = x;
  }
  LDS_BARRIER();
}
DI void stage_cols(const f32x4 (&v)[4][4], unsigned char* lds, bf16_t* dst) {
  const int tid = opaque_tid(), lane = tid & 63, w = tid >> 6, wm = w >> 1, wn = w & 1, l15 = lane & 15, quad = lane >> 4;
#pragma unroll
  for (int mt = 0; mt < 4; ++mt)
#pragma unroll
    for (int nt = 0; nt < 4; ++nt)
      *(u32x2*)(lds + (wn * 64 + nt * 16 + l15) * 528 + (wm * 64 + mt * 16 + quad * 4) * 2) = pk4(v[mt][nt]);
  LDS_BARRIER();
#pragma unroll
  for (int i = 0; i < 8; ++i) {
    const int id = tid + 512 * i, row = id >> 5, ch = id & 31;
    const u32x4 x = *(const u32x4*)(lds + row * 528 + ch * 16);
    *(u32x4*)(dst + (size_t)row * TT + ch * 8) = x;
  }
  LDS_BARRIER();
}

DI void inproj_epi(const Params& p, f32x4 (&acc)[4][4], int tm, int tn, unsigned char* lds) {
  unsigned char* act = p.ws + OFF_ACT;
  const float2* rope = (const float2*)(p.ws + OFF_ROPE);
  const int bl = tm / 9, tt = tm - bl * 9;
  const bool latent = tt < 8;
  const int r0 = tm * 256, t0 = tt * 256;
  {
    const int tid = opaque_tid(), lane = tid & 63, w = tid >> 6, wm = w >> 1, wn = w & 1, l15 = lane & 15, quad = lane >> 4;
    const int wt0 = t0 + wm * 64;
    if (tn < 4) {
      stage_rows<4>(acc, lds, (bf16_t*)(act + A_GQK) + (size_t)r0 * 1024 + tn * 128, 1024, 0.08838834764831845f);
    } else if (tn < 8) {
      stage_rows<4>(acc, lds, (bf16_t*)(act + A_GQK) + (size_t)r0 * 1024 + 512 + (tn - 4) * 128, 1024, 1.0f);
    } else if (tn < 16) {
      stage_cols(acc, lds, (bf16_t*)(act + A_GVT) + ((size_t)bl * 1024 + (tn - 8) * 128) * TT + t0);
    } else if (tn < 24) {
      stage_rows<4>(acc, lds, (bf16_t*)(act + A_GG) + (size_t)r0 * 1024 + (tn - 16) * 128, 1024, 1.0f);
    } else if (tn < 32) {
      if (latent) rope_acc(acc, rope, wt0, l15, quad);
      stage_rows<4>(acc, lds, (bf16_t*)(act + A_SQ) + (size_t)r0 * 1024 + (tn - 24) * 128, 1024, 0.125f * LOG2E);
    } else if (tn == 32) {
      if (latent) rope_acc(acc, rope, wt0, l15, quad);
      stage_rows<4>(acc, lds, (bf16_t*)(act + A_SK) + (size_t)r0 * 128, 128, 1.0f);
    } else if (tn == 33) {
      stage_cols(acc, lds, (bf16_t*)(act + A_SVT) + ((size_t)bl * 128) * TT + t0);
    } else if (tn < 39) {
      float* rsq = (float*)(p.ws + OFF_RSQ) + (tn < 37 ? 0 : R) + r0;
#pragma unroll
      for (int mt = 0; mt < 4; ++mt) {
        float ss = 0.f;
#pragma unroll
        for (int nt = 0; nt < 4; ++nt) { const f32x4 v = acc[mt][nt]; ss += v[0] * v[0] + v[1] * v[1] + v[2] * v[2] + v[3] * v[3]; }
        ss += shx(ss, lane, 16); ss += shx(ss, lane, 32);
        if (quad == 0) atomicAdd(rsq + wm * 64 + mt * 16 + l15, ss);
      }
      if (tn < 37) stage_rows<4>(acc, lds, (bf16_t*)(act + A_CQ) + (size_t)r0 * 384 + (tn - 34) * 128, 384, 1.0f);
      else stage_rows<4>(acc, lds, (bf16_t*)(act + A_CKV) + (size_t)r0 * 256 + (tn - 37) * 128, 256, 1.0f);
    } else if (tn == 39) {
      if (wn == 0) {
        if (latent) rope_acc(acc, rope, wt0, l15, quad);
        store_rows_direct(acc, (bf16_t*)(act + A_KR) + (size_t)r0 * 64, 64, wm, l15, quad, 1.0f);
      } else {
        float* gkr = (float*)(act + A_GKR);
#pragma unroll
        for (int mt = 0; mt < 4; ++mt)
#pragma unroll
          for (int nt = 0; nt < 2; ++nt)
            *(f32x4*)(gkr + (size_t)(r0 + wm * 64 + mt * 16 + l15) * 32 + nt * 16 + quad * 4) = acc[mt][nt];
      }
    } else {
#pragma unroll
      for (int mt = 0; mt < 4; ++mt)
#pragma unroll
        for (int nt = 0; nt < 4; ++nt) {
          f32x4 v = acc[mt][nt];
          v[0] = fmaxf(sigmoidf_(v[0]), 1e-6f); v[1] = fmaxf(sigmoidf_(v[1]), 1e-6f); v[2] = fmaxf(sigmoidf_(v[2]), 1e-6f); v[3] = fmaxf(sigmoidf_(v[3]), 1e-6f);
          acc[mt][nt] = v;
        }
      stage_rows<4>(acc, lds, (bf16_t*)(act + A_MG) + (size_t)r0 * 3072 + (tn - 40) * 128, 3072, 1.0f);
    }
  }
}
DI void inproj_phase(const Params& p, int g, unsigned char* lds) {
  unsigned char* act = p.ws + OFF_ACT;
  const bf16_t* H = (const bf16_t*)(act + A_H);
  const bf16_t* W = (const bf16_t*)(p.ws + OFF_WM + WM_WIN);
  const int nunits = (R / 256) * 33;
  (void)nunits;
  for (int i_ = 0;; ++i_) {
    int tm, u;
    if (!unit_order(i_, R / 256, 33, tm, u)) break;
    const int r0 = tm * 256;
    if (u < 31) {
      const int tn0 = 2 * (u < 16 ? u : u + 1);
      f32x4 acc0[4][4], acc1[4][4]; zero_acc(acc0); zero_acc(acc1);
      if (tn0 >= 8 && tn0 < 16) gemm_tile2<false>(H + (size_t)r0 * 1024, 1024, W + (size_t)tn0 * 128 * 1024, 1024, 1024, lds, acc0, acc1);
      else gemm_tile2<true>(H + (size_t)r0 * 1024, 1024, W + (size_t)tn0 * 128 * 1024, 1024, 1024, lds, acc0, acc1);
      inproj_epi(p, acc0, tm, tn0, lds);
      inproj_epi(p, acc1, tm, tn0 + 1, lds);
    } else {
      const int tn = u + 1;
      f32x4 acc[4][4]; zero_acc(acc);
      if (tn == 33) gemm_tile<false, false>(H + (size_t)r0 * 1024, 1024, W + (size_t)tn * 128 * 1024, 1024, 1024, lds, acc);
      else gemm_tile<true, false>(H + (size_t)r0 * 1024, 1024, W + (size_t)tn * 128 * 1024, 1024, 1024, lds, acc);
      inproj_epi(p, acc, tm, tn, lds);
    }
  }
}

template <int K>
DI void row_rstd(const bf16_t* __restrict__ A, float* rs, int tid) {
  const int row = tid >> 1, half = tid & 1;
  const bf16_t* ap = A + (size_t)row * K + half * (K / 2);
  float ss = 0.f;
#pragma unroll 4
  for (int c = 0; c < K / 16; ++c) {
    const u32x4 v = *(const u32x4*)(ap + c * 8);
#pragma unroll
    for (int j = 0; j < 4; ++j) { const float a = bflo(v[j]), b = bfhi(v[j]); ss += a * a + b * b; }
  }
  ss += shx(ss, tid & 63, 1);
  if (half == 0) rs[row] = rsqrtf(ss / (float)K + 1e-6f);
}
DI void mlaup_phase(const Params& p, bool last, unsigned char* lds) {
  unsigned char* act = p.ws + OFF_ACT;
  const float2* rope = (const float2*)(p.ws + OFF_ROPE);
  const float* rsq_q = (const float*)(p.ws + OFF_RSQ);
  const float* rsq_kv = rsq_q + R;
  const int nrt_q = last ? BG * 8 : BG * 9;
  const int nq = nrt_q * 12, nkv = (R / 256) * 16;
  const int G_ = gridDim.x, b_ = blockIdx.x;
  for (int id = b_; id < nq; id += G_) {
    const int tid = opaque_tid(), lane = tid & 63, w = tid >> 6, wm = w >> 1, wn = w & 1, l15 = lane & 15, quad = lane >> 4;
    const int rt = id / 12, tn = id - rt * 12;
    const int tm = last ? (rt / 8) * 9 + (rt & 7) : rt;
    const int bl = tm / 9, tt = tm - bl * 9;
    const bool latent = tt < 8;
    const int r0 = tm * 256, t0 = tt * 256;
    const bf16_t* A = (const bf16_t*)(act + A_CQ) + (size_t)r0 * 384;
    f32x4 acc[4][4]; zero_acc(acc);
    gemm_tile<true, false>(A, 384, (const bf16_t*)(p.ws + OFF_WM + WM_WQU) + (size_t)tn * 128 * 384, 384, 384, lds, acc);
    const float sc = 0.07216878364870322f * LOG2E;
#pragma unroll
    for (int mt = 0; mt < 4; ++mt) { const float rv = rsqrtf(rsq_q[r0 + wm * 64 + mt * 16 + l15] * (1.0f / 384.0f) + 1e-6f) * sc;
#pragma unroll
      for (int nt = 0; nt < 4; ++nt) acc[mt][nt] *= rv; }
    const int g64 = tn * 2 + wn;
    if ((g64 % 3) == 2 && latent) rope_acc(acc, rope, t0 + wm * 64, l15, quad);
    stage_rows<4>(acc, lds, (bf16_t*)(act + A_QF) + (size_t)r0 * 1536 + tn * 128, 1536, 1.0f);
    __syncthreads();
  }
  for (int gid = b_ + ((nq - b_ + G_ - 1) / G_) * G_; gid < nq + nkv; gid += G_) {
    const int id = gid - nq;
    const int tid = opaque_tid(), lane = tid & 63, w = tid >> 6, wm = w >> 1, wn = w & 1, l15 = lane & 15, quad = lane >> 4;
    const int tm = id >> 4, tn = id & 15;
    const int bl = tm / 9, tt = tm - bl * 9;
    const int r0 = tm * 256, t0 = tt * 256;
    const bf16_t* A = (const bf16_t*)(act + A_CKV) + (size_t)r0 * 256;
    f32x4 acc[4][4]; zero_acc(acc);
    const bf16_t* W = (const bf16_t*)(p.ws + OFF_WM + WM_WKVU) + (size_t)tn * 128 * 256;
    if (tn & 1) {
      gemm_tile<false, false>(A, 256, W, 256, 256, lds, acc);
#pragma unroll
      for (int mt = 0; mt < 4; ++mt) {
        f32x4 rv = *(const f32x4*)(rsq_kv + r0 + wm * 64 + mt * 16 + quad * 4);
        rv[0] = rsqrtf(rv[0] * (1.0f / 256.0f) + 1e-6f); rv[1] = rsqrtf(rv[1] * (1.0f / 256.0f) + 1e-6f); rv[2] = rsqrtf(rv[2] * (1.0f / 256.0f) + 1e-6f); rv[3] = rsqrtf(rv[3] * (1.0f / 256.0f) + 1e-6f);
#pragma unroll
        for (int nt = 0; nt < 4; ++nt) acc[mt][nt] *= rv;
      }
      stage_cols(acc, lds, (bf16_t*)(act + A_VT) + ((size_t)bl * 1024 + (tn >> 1) * 128) * TT + t0);
    } else {
      gemm_tile<true, false>(A, 256, W, 256, 256, lds, acc);
#pragma unroll
      for (int mt = 0; mt < 4; ++mt) { const float rv = rsqrtf(rsq_kv[r0 + wm * 64 + mt * 16 + l15] * (1.0f / 256.0f) + 1e-6f);
#pragma unroll
        for (int nt = 0; nt < 4; ++nt) acc[mt][nt] *= rv; }
      stage_rows<4>(acc, lds, (bf16_t*)(act + A_KN) + (size_t)r0 * 1024 + (tn >> 1) * 128, 1024, 1.0f);
    }
    __syncthreads();
  }
}

template <int DKS, int NVT, int MT, bool MLA, bool HP = false>
DI void attn_item(const bf16_t* Qp, int ldq, bf16_t* Op, int ldo, const bf16_t* __restrict__ K1, int ldk1,
                  const bf16_t* __restrict__ K2, const bf16_t* __restrict__ Vt, int qrow0  , int qt0  ,
                  int krow0  , int ta0, int ta1, int tb0, int tb1, bool maskwin, bool has_sink, const float* sinkp,
                  unsigned char* lds) {
  constexpr int DK = DKS * 32, DV = NVT * 16, KSTR = DK * 2, KCH = DK / 8, KBYTES = 64 * KSTR, VBYTES = DV * 144, BUFB = KBYTES + VBYTES;
  const int tid = opaque_tid(), lane = tid & 63, w = tid >> 6, l15 = lane & 15, quad = lane >> 4;
  bf16x8 qf[MT][DKS];
#pragma unroll
  for (int mt = 0; mt < MT; ++mt)
#pragma unroll
    for (int ks = 0; ks < DKS; ++ks)
      qf[mt][ks] = *(const bf16x8*)(Qp + (size_t)(qrow0 + (HP ? w * 16 : w * 16 * MT + mt * 16) + l15) * ldq + (HP ? mt * 64 : 0) + ks * 32 + quad * 8);
  f32x4 o[MT][NVT];
  float mrow[MT], lrow[MT];
#pragma unroll
  for (int mt = 0; mt < MT; ++mt) {
    mrow[mt] = has_sink ? sinkp[HP ? mt : 0] * LOG2E : -INFINITY;
    lrow[mt] = (has_sink && quad == 0) ? 1.0f : 0.0f;
#pragma unroll
    for (int nv = 0; nv < NVT; ++nv) o[mt][nv] = (f32x4){0.f, 0.f, 0.f, 0.f};
  }
  const int na = ta1 - ta0, ntl = na + (tb1 - tb0);
  constexpr int NKL = (64 * KCH) / 512;
  constexpr int NVL = (DV * 8) / 512;
  u32x4 rk[NKL], rv[NVL];
#define AT_LOAD(J) do { const int kt_ = (J) < na ? ta0 + (J) : tb0 + ((J) - na); const size_t kr0_ = (size_t)krow0 + (size_t)kt_ * 64; \
    _Pragma("unroll") for (int i = 0; i < NKL; ++i) { const int idx = tid + 512 * i, key = idx / KCH, cc = idx - key * KCH; \
      if (MLA) rk[i] = (cc < 16) ? *(const u32x4*)(K1 + (kr0_ + key) * ldk1 + cc * 8) : *(const u32x4*)(K2 + (kr0_ + key) * 64 + (cc - 16) * 8); \
      else rk[i] = *(const u32x4*)(K1 + (kr0_ + key) * ldk1 + cc * 8); } \
    _Pragma("unroll") for (int i = 0; i < NVL; ++i) { const int idx = tid + 512 * i, dv = idx >> 3, cc = idx & 7; \
      rv[i] = *(const u32x4*)(Vt + (size_t)dv * TT + kt_ * 64 + cc * 8); } } while (0)
#define AT_STORE(BUF) do { unsigned char* ks_ = lds + (BUF) * BUFB; unsigned char* vs_ = ks_ + KBYTES; \
    _Pragma("unroll") for (int i = 0; i < NKL; ++i) { const int idx = tid + 512 * i, key = idx / KCH, cc = idx - key * KCH; \
      *(u32x4*)(ks_ + key * KSTR + (((cc & ~7) | ((cc & 7) ^ ((key >> 1) & 7))) * 16)) = rk[i]; } \
    _Pragma("unroll") for (int i = 0; i < NVL; ++i) { const int idx = tid + 512 * i, dv = idx >> 3, cc = idx & 7; *(u32x4*)(vs_ + dv * 144 + cc * 16) = rv[i]; } } while (0)
  AT_LOAD(0);
  AT_STORE(0);
  if (ntl > 1) AT_LOAD(1);
  LDS_BARRIER();
  const int ksw = (l15 >> 1) & 7;
  for (int j = 0; j < ntl; ++j) {
    const unsigned char* Ks = lds + (j & 1) * BUFB;
    const unsigned char* Vs = Ks + KBYTES;
    const int kt = j < na ? ta0 + j : tb0 + (j - na);
    const bool masked = maskwin && (j < na);
    f32x4 s[MT][4];
#pragma unroll
    for (int mt = 0; mt < MT; ++mt)
#pragma unroll
      for (int nt = 0; nt < 4; ++nt) s[mt][nt] = (f32x4){0.f, 0.f, 0.f, 0.f};
#pragma unroll
    for (int nt = 0; nt < 4; ++nt)
#pragma unroll
      for (int ks = 0; ks < DKS; ++ks) {
        const int cc = ks * 4 + quad;
        const bf16x8 kf = *(const bf16x8*)(Ks + (nt * 16 + l15) * KSTR + (((cc & ~7) | ((cc & 7) ^ ksw)) * 16));
#pragma unroll
        for (int mt = 0; mt < MT; ++mt) s[mt][nt] = MFMA16(kf, qf[mt][ks], s[mt][nt]);
      }
    bf16x8 pb[MT][2];
#pragma unroll
    for (int mt = 0; mt < MT; ++mt) {
      if (masked) {
        const int tq = qt0 + (HP ? w * 16 : w * 16 * MT + mt * 16) + l15;
#pragma unroll
        for (int nt = 0; nt < 4; ++nt)
#pragma unroll
          for (int i = 0; i < 4; ++i) {
            const int d = kt * 64 + nt * 16 + quad * 4 + i - tq;
            if (d > 128 || d < -128) s[mt][nt][i] = -INFINITY;
          }
      }
      float mx = s[mt][0][0];
#pragma unroll
      for (int nt = 0; nt < 4; ++nt)
#pragma unroll
        for (int i = 0; i < 4; ++i) mx = fmaxf(mx, s[mt][nt][i]);
      mx = fmaxf(mx, shx(mx, lane, 16));
      mx = fmaxf(mx, shx(mx, lane, 32));
      const float mnew = fmaxf(mrow[mt], mx);
      const float alpha = (mnew == -INFINITY) ? 1.0f : __builtin_amdgcn_exp2f(mrow[mt] - mnew);
      const float msub = (mnew == -INFINITY) ? 0.0f : mnew;
      mrow[mt] = mnew;
      float ps = 0.f;
#pragma unroll
      for (int nt = 0; nt < 4; ++nt)
#pragma unroll
        for (int i = 0; i < 4; ++i) { const float pv = __builtin_amdgcn_exp2f(s[mt][nt][i] - msub); s[mt][nt][i] = pv; ps += pv; }
      lrow[mt] = lrow[mt] * alpha + ps;
      if (__any(alpha != 1.0f)) {
#pragma unroll
        for (int nv = 0; nv < NVT; ++nv) o[mt][nv] *= alpha;
      }
#pragma unroll
      for (int k2 = 0; k2 < 2; ++k2) {
        u32x4 pw;
        pw[0] = pk2(s[mt][2 * k2][0], s[mt][2 * k2][1]); pw[1] = pk2(s[mt][2 * k2][2], s[mt][2 * k2][3]);
        pw[2] = pk2(s[mt][2 * k2 + 1][0], s[mt][2 * k2 + 1][1]); pw[3] = pk2(s[mt][2 * k2 + 1][2], s[mt][2 * k2 + 1][3]);
        pb[mt][k2] = __builtin_bit_cast(bf16x8, pw);
      }
    }
#pragma unroll
    for (int nv = 0; nv < NVT; ++nv)
#pragma unroll
      for (int k2 = 0; k2 < 2; ++k2) {
        const s16x4 lo = *(const s16x4*)(Vs + (nv * 16 + l15) * 144 + k2 * 64 + quad * 8);
        const s16x4 hi = *(const s16x4*)(Vs + (nv * 16 + l15) * 144 + k2 * 64 + 32 + quad * 8);
        const bf16x8 vf = __builtin_shufflevector(lo, hi, 0, 1, 2, 3, 4, 5, 6, 7);
#pragma unroll
        for (int mt = 0; mt < MT; ++mt) o[mt][nv] = MFMA16(vf, pb[mt][k2], o[mt][nv]);
      }
    if (j + 1 < ntl) {
      AT_STORE((j + 1) & 1);
      if (j + 2 < ntl) AT_LOAD(j + 2);
    }
    LDS_BARRIER();
  }
#undef AT_LOAD
#undef AT_STORE
#pragma unroll
  for (int mt = 0; mt < MT; ++mt) {
    float lt = lrow[mt];
    lt += shx(lt, lane, 16);
    lt += shx(lt, lane, 32);
    const float inv = 1.0f / lt;
    bf16_t* op = Op + (size_t)(qrow0 + (HP ? w * 16 : w * 16 * MT + mt * 16) + l15) * ldo + (HP ? mt * 64 : 0) + quad * 4;
#pragma unroll
    for (int nv = 0; nv < NVT; ++nv) *(u32x2*)(op + nv * 16) = pk4(o[mt][nv] * inv);
  }
  __syncthreads();
}

DI void gla_chain(const Params& p, int l, int bl, int h, int sl, int dir, unsigned char* lds) {
  unsigned char* act = p.ws + OFF_ACT;
  const bf16_t* GQK = (const bf16_t*)(act + A_GQK);
  const bf16_t* GVT = (const bf16_t*)(act + A_GVT);
  const float* GKR = (const float*)(act + A_GKR);
  bf16_t* OUT = (bf16_t*)(act + (dir ? A_OB : A_H));
  unsigned char* QD = lds + L_QD; unsigned char* KI = lds + L_KI; unsigned char* KET = lds + L_KET; unsigned char* VTs = lds + L_VT; unsigned char* STs = lds + L_ST;
  float* WG = (float*)(lds + L_WG); float* BGs = (float*)(lds + L_BG); float* ETOT = (float*)(lds + L_ETOT);
  const int tid = opaque_tid(), lane = tid & 63, w = tid >> 6, l15 = lane & 15, quad = lane >> 4;
  {
    const float* wg = (dir ? p.w_gk_bwd : p.w_gk_fwd) + (size_t)l * 16 * 512 + h * 128;
    const float* bgp = (dir ? p.b_gk_bwd : p.b_gk_fwd) + (size_t)l * 512 + h * 128;
    for (int i = tid; i < 2048; i += 512) WG[i] = wg[(i >> 7) * 512 + (i & 127)];
    if (tid < 128) BGs[tid] = bgp[tid];
    for (int i = tid; i < 17408 / 4; i += 512) ((unsigned*)STs)[i] = 0u;
  }
  f32x4 S[4];
#pragma unroll
  for (int i = 0; i < 4; ++i) S[i] = (f32x4){0.f, 0.f, 0.f, 0.f};
  u32x4 rq0, rq1, rk0, rk1, rvv; float4 g0, g1, g2, g3;
  const int vv_ = tid >> 3, vch_ = tid & 7;
#define GLA_LOAD(U) do { const int row0_ = bl * TT + (U) * 64; \
    const bf16_t* qp_ = GQK + (size_t)(row0_ + lane) * 1024 + h * 128 + w * 16; \
    rq0 = *(const u32x4*)(qp_); rq1 = *(const u32x4*)(qp_ + 8); rk0 = *(const u32x4*)(qp_ + 512); rk1 = *(const u32x4*)(qp_ + 520); \
    rvv = *(const u32x4*)(GVT + ((size_t)bl * 1024 + h * 256 + sl * 64 + vv_) * TT + (U) * 64 + vch_ * 8); \
    const float* gp_ = GKR + (size_t)(row0_ + lane) * 32 + dir * 16; \
    g0 = *(const float4*)(gp_); g1 = *(const float4*)(gp_ + 4); g2 = *(const float4*)(gp_ + 8); g3 = *(const float4*)(gp_ + 12); } while (0)
  GLA_LOAD(dir ? 35 : 32);
  __syncthreads();
  for (int step = 0; step < 36; ++step) {
    const int u = dir ? (35 - step) : (step < 4 ? 32 + step : step - 4);
    const int row0 = bl * TT + u * 64;
    LDS_BARRIER();
    {
      const float gk[16] = {g0.x, g0.y, g0.z, g0.w, g1.x, g1.y, g1.z, g1.w, g2.x, g2.y, g2.z, g2.w, g3.x, g3.y, g3.z, g3.w};
      f32x2_t z2[8];
#pragma unroll
      for (int j4 = 0; j4 < 4; ++j4) { const float4 bv = *(const float4*)(BGs + w * 16 + j4 * 4); z2[2 * j4] = (f32x2_t){bv.x, bv.y}; z2[2 * j4 + 1] = (f32x2_t){bv.z, bv.w}; }
#pragma unroll
      for (int r = 0; r < 16; ++r) {
        const f32x2_t g2 = (f32x2_t){gk[r], gk[r]};
#pragma unroll
        for (int j4 = 0; j4 < 4; ++j4) {
          const float4 wv = *(const float4*)(WG + r * 128 + w * 16 + j4 * 4);
          z2[2 * j4] = g2 * (f32x2_t){wv.x, wv.y} + z2[2 * j4];
          z2[2 * j4 + 1] = g2 * (f32x2_t){wv.z, wv.w} + z2[2 * j4 + 1];
        }
      }
      float la[16], x[16];
#pragma unroll
      for (int j = 0; j < 16; ++j) {
        const float z = (j & 1) ? z2[j >> 1][1] : z2[j >> 1][0];
        const float t = __builtin_amdgcn_exp2f(-fabsf(z) * LOG2E);
        la[j] = (fminf(z, 0.f) - __builtin_amdgcn_logf(1.0f + t) * 0.6931471805599453f) * (1.0f / 16.0f);
        x[j] = la[j];
      }
#pragma unroll
      for (int j = 0; j < 16; ++j) x[j] += dpp_move<0x111, 0xF, true>(x[j]);
#pragma unroll
      for (int j = 0; j < 16; ++j) x[j] += dpp_move<0x112, 0xF, true>(x[j]);
#pragma unroll
      for (int j = 0; j < 16; ++j) x[j] += dpp_move<0x114, 0xF, true>(x[j]);
#pragma unroll
      for (int j = 0; j < 16; ++j) x[j] += dpp_move<0x118, 0xF, true>(x[j]);
#pragma unroll
      for (int j = 0; j < 16; ++j) x[j] += dpp_move<0x142, 0xA, false>(x[j]);
#pragma unroll
      for (int j = 0; j < 16; ++j) x[j] += dpp_move<0x143, 0xC, false>(x[j]);
      float qd[16], ki[16], et[16];
#pragma unroll
      for (int j = 0; j < 16; ++j) {
        const float tot = __builtin_bit_cast(float, __builtin_amdgcn_readlane(__builtin_bit_cast(int, x[j]), 63));
        const float cum = dir ? (tot - x[j] + la[j]) : x[j];
        const float e = __builtin_amdgcn_exp2f(cum * LOG2E);
        const float ie = __builtin_amdgcn_rcpf(e);
        const float etv = __builtin_amdgcn_exp2f(tot * LOG2E);
        et[j] = etv;
        const unsigned qw = (j < 8) ? rq0[(j & 7) >> 1] : rq1[(j & 7) >> 1];
        const unsigned kw = (j < 8) ? rk0[(j & 7) >> 1] : rk1[(j & 7) >> 1];
        const float qv = (j & 1) ? bfhi(qw) : bflo(qw);
        const float kv = (j & 1) ? bfhi(kw) : bflo(kw);
        qd[j] = qv * e; ki[j] = kv * ie;
        *(bf16_t*)(KET + ((w * 16 + j) * 72 + lane) * 2) = f2bf(kv * etv * ie);
      }
#pragma unroll
      for (int i = 0; i < 2; ++i) {
        u32x4 a, b;
#pragma unroll
        for (int j = 0; j < 4; ++j) { a[j] = pk2(qd[8 * i + 2 * j], qd[8 * i + 2 * j + 1]); b[j] = pk2(ki[8 * i + 2 * j], ki[8 * i + 2 * j + 1]); }
        *(u32x4*)(QD + (lane * 136 + w * 16 + 8 * i) * 2) = a;
        *(u32x4*)(KI + (lane * 136 + w * 16 + 8 * i) * 2) = b;
      }
      if (lane == 0) {
#pragma unroll
        for (int j4 = 0; j4 < 4; ++j4) *(f32x4*)(ETOT + w * 16 + j4 * 4) = (f32x4){et[4 * j4], et[4 * j4 + 1], et[4 * j4 + 2], et[4 * j4 + 3]};
      }
      *(u32x4*)(VTs + (vv_ * 72 + vch_ * 8) * 2) = rvv;
    }
    LDS_BARRIER();
    if (step + 1 < 36) { const int un = dir ? (34 - step) : (step + 1 < 4 ? 33 + step : step - 3); GLA_LOAD(un); }
    {
      const int ct = w & 3, vh = w >> 2;
      bf16x8 qdf[4];
#pragma unroll
      for (int ks = 0; ks < 4; ++ks) qdf[ks] = *(const bf16x8*)(QD + ((ct * 16 + l15) * 136 + ks * 32 + quad * 8) * 2);
      f32x4 sc[4];
#pragma unroll
      for (int nt = 0; nt < 4; ++nt) {
        sc[nt] = (f32x4){0.f, 0.f, 0.f, 0.f};
#pragma unroll
        for (int ks = 0; ks < 4; ++ks) {
          const bf16x8 kf = *(const bf16x8*)(KI + ((nt * 16 + l15) * 136 + ks * 32 + quad * 8) * 2);
          sc[nt] = MFMA16(kf, qdf[ks], sc[nt]);
        }
        const int cidx = ct * 16 + l15;
#pragma unroll
        for (int i = 0; i < 4; ++i) {
          const int sidx = nt * 16 + quad * 4 + i;
          const bool keep = dir ? (sidx > cidx) : (sidx <= cidx);
          if (!keep) sc[nt][i] = 0.f;
        }
      }
      bf16x8 pb[2];
#pragma unroll
      for (int k2 = 0; k2 < 2; ++k2) {
        u32x4 pw;
        pw[0] = pk2(sc[2 * k2][0], sc[2 * k2][1]); pw[1] = pk2(sc[2 * k2][2], sc[2 * k2][3]);
        pw[2] = pk2(sc[2 * k2 + 1][0], sc[2 * k2 + 1][1]); pw[3] = pk2(sc[2 * k2 + 1][2], sc[2 * k2 + 1][3]);
        pb[k2] = __builtin_bit_cast(bf16x8, pw);
      }
#pragma unroll
      for (int nv = 0; nv < 2; ++nv) {
        const int vrow = vh * 32 + nv * 16 + l15;
        f32x4 oo = (f32x4){0.f, 0.f, 0.f, 0.f};
#pragma unroll
        for (int k2 = 0; k2 < 2; ++k2) {
          const s16x4 lo = *(const s16x4*)(VTs + (vrow * 72 + k2 * 32 + quad * 4) * 2);
          const s16x4 hi = *(const s16x4*)(VTs + (vrow * 72 + k2 * 32 + 16 + quad * 4) * 2);
          const bf16x8 vf = __builtin_shufflevector(lo, hi, 0, 1, 2, 3, 4, 5, 6, 7);
          oo = MFMA16(vf, pb[k2], oo);
        }
#pragma unroll
        for (int ks = 0; ks < 4; ++ks) {
          const bf16x8 sf = *(const bf16x8*)(STs + (vrow * 136 + ks * 32 + quad * 8) * 2);
          oo = MFMA16(sf, qdf[ks], oo);
        }
        *(u32x2*)(OUT + (size_t)(row0 + ct * 16 + l15) * 1024 + h * 256 + sl * 64 + vh * 32 + nv * 16 + quad * 4) = pk4(oo);
      }
    }
    LDS_BARRIER();
    {
      const f32x4 dec = *(const f32x4*)(ETOT + w * 16 + quad * 4);
#pragma unroll
      for (int vt = 0; vt < 4; ++vt) S[vt] *= dec;
#pragma unroll
      for (int k2 = 0; k2 < 2; ++k2) {
        const bf16x8 kef = *(const bf16x8*)(KET + ((w * 16 + l15) * 72 + k2 * 32 + quad * 8) * 2);
#pragma unroll
        for (int vt = 0; vt < 4; ++vt) {
          const bf16x8 vf = *(const bf16x8*)(VTs + ((vt * 16 + l15) * 72 + k2 * 32 + quad * 8) * 2);
          S[vt] = MFMA16(kef, vf, S[vt]);
        }
      }
#pragma unroll
      for (int vt = 0; vt < 4; ++vt) *(u32x2*)(STs + ((vt * 16 + l15) * 136 + w * 16 + quad * 4) * 2) = pk4(S[vt]);
    }
  }
#undef GLA_LOAD
  __syncthreads();
}

DI void mixers_phase(const Params& p, int l, int g, bool last, unsigned char* lds) {
  unsigned char* act = p.ws + OFF_ACT;
  const int xcd = blockIdx.x & 7;
  unsigned* ctr = (unsigned*)(p.ws + OFF_CTR) + ((l * NGRP + g) * 8 + xcd);
  int* s_item = (int*)(lds + L_ITEM);
  const int n_gla = BG * 4 * 4 * 2, n_mla = BG * 8 * 8, n_swa = BG * 4 * 16, n_mlac = last ? 0 : BG * 8, n_swac = last ? 0 : BG * 16 * 2;
  const int total = n_gla + n_mla + n_swa + n_mlac + n_swac;
  for (;;) {
    if (opaque_tid() == 0) *s_item = (int)atomicAdd(ctr, 1u);
    __syncthreads();
    int it = *s_item;
    __syncthreads();
    if (it >= total / 8) break;
    if (it < n_gla / 8) {
      it += xcd * (n_gla / 8);
      const int dir = it & 1, sl = (it >> 1) & 3, h = (it >> 3) & 3, bl = it >> 5;
      gla_chain(p, l, bl, h, sl, dir, lds);
      continue;
    }
    it -= n_gla / 8;
    if (it < n_mla / 8) {
      it += xcd * (n_mla / 8);
      const int bl = it >> 6, h = (it >> 3) & 7, qb = it & 7;
      bf16_t* QF = (bf16_t*)(act + A_QF) + h * 192;
      attn_item<6, 8, 2, true>(QF, 1536, QF, 1536, (const bf16_t*)(act + A_KN) + h * 128, 1024, (const bf16_t*)(act + A_KR),
                               (const bf16_t*)(act + A_VT) + ((size_t)bl * 1024 + h * 128) * TT, bl * TT + qb * 256, qb * 256, bl * TT, 0, 36, 0, 0,
                               false, false, nullptr, lds);
      continue;
    }
    it -= n_mla / 8;
    if (it < n_swa / 8) {
      it += xcd * (n_swa / 8);
      const int bl = it >> 6, gk = (it >> 5) & 1, hh = (it >> 4) & 1, qi = it & 15, hq0 = gk * 8 + hh * 4;
      bf16_t* SQ = (bf16_t*)(act + A_SQ) + hq0 * 64;
      const int a0 = (2 * qi - 2) < 0 ? 0 : (2 * qi - 2), a1 = (2 * qi + 4) > 32 ? 32 : (2 * qi + 4);
      attn_item<2, 4, 4, false, true>(SQ, 1024, SQ, 1024, (const bf16_t*)(act + A_SK) + gk * 64, 128, nullptr,
                                      (const bf16_t*)(act + A_SVT) + ((size_t)bl * 128 + gk * 64) * TT, bl * TT + qi * 128, qi * 128, bl * TT, a0, a1, 32, 36,
                                      true, true, p.sinks + l * 16 + hq0, lds);
      continue;
    }
    it -= n_swa / 8;
    if (it < n_mlac / 8) {
      it += xcd * (n_mlac / 8);
      const int bl = it >> 3, h = it & 7;
      bf16_t* QF = (bf16_t*)(act + A_QF) + h * 192;
      attn_item<6, 8, 2, true>(QF, 1536, QF, 1536, (const bf16_t*)(act + A_KN) + h * 128, 1024, (const bf16_t*)(act + A_KR),
                               (const bf16_t*)(act + A_VT) + ((size_t)bl * 1024 + h * 128) * TT, bl * TT + 2048, 2048, bl * TT, 32, 36, 0, 0,
                               false, false, nullptr, lds);
      continue;
    }
    it -= n_mlac / 8;
    {
      it += xcd * (n_swac / 8);
      const int bl = it >> 5, hq = (it >> 1) & 15, half = it & 1, gk = hq >> 3;
      bf16_t* SQ = (bf16_t*)(act + A_SQ) + hq * 64;
      attn_item<2, 4, 1, false>(SQ, 1024, SQ, 1024, (const bf16_t*)(act + A_SK) + gk * 64, 128, nullptr,
                                (const bf16_t*)(act + A_SVT) + ((size_t)bl * 128 + gk * 64) * TT, bl * TT + 2048 + half * 128, 2048 + half * 128, bl * TT,
                                32, 36, 0, 0, false, true, p.sinks + l * 16 + hq, lds);
    }
  }
}

DI void glapost_phase(const Params& p, int l) {
  unsigned char* act = p.ws + OFF_ACT;
  const bf16_t* OF = (const bf16_t*)(act + A_H);
  const bf16_t* OB = (const bf16_t*)(act + A_OB);
  bf16_t* GG = (bf16_t*)(act + A_GG);
  const float* gn = p.gla_norm + l * 256;
  const int tid = opaque_tid(), lane = tid & 63, w = tid >> 6;
  for (int r = blockIdx.x * 8 + w; r < R; r += gridDim.x * 8) {
    const size_t off = (size_t)r * 1024 + lane * 16;
    float v[16];
    float ss = 0.f;
#pragma unroll
    for (int c = 0; c < 2; ++c) {
      const u32x4 a = *(const u32x4*)(OF + off + c * 8), b = *(const u32x4*)(OB + off + c * 8);
#pragma unroll
      for (int j = 0; j < 4; ++j) { v[c * 8 + 2 * j] = bflo(a[j]) + bflo(b[j]); v[c * 8 + 2 * j + 1] = bfhi(a[j]) + bfhi(b[j]); }
    }
#pragma unroll
    for (int j = 0; j < 16; ++j) ss += v[j] * v[j];
#pragma unroll
    for (int o = 8; o >= 1; o >>= 1) ss += shx(ss, lane, o);
    const float rstd = rsqrtf(ss * (1.0f / 256.0f) + 1e-6f);
    const int vcol = (lane & 15) * 16;
#pragma unroll
    for (int c = 0; c < 2; ++c) {
      const u32x4 gq = *(const u32x4*)(GG + off + c * 8);
      u32x4 o;
#pragma unroll
      for (int j = 0; j < 4; ++j) {
        const float g0 = bflo(gq[j]), g1 = bfhi(gq[j]);
        const float y0 = v[c * 8 + 2 * j] * rstd * gn[vcol + c * 8 + 2 * j] * siluf_(g0);
        const float y1 = v[c * 8 + 2 * j + 1] * rstd * gn[vcol + c * 8 + 2 * j + 1] * siluf_(g1);
        o[j] = pk2(y0, y1);
      }
      *(u32x4*)(GG + off + c * 8) = o;
    }
  }
}

#define MERGE_SCALE_T(ACC, NTT, BR, COL0) do { \
      const int tid = opaque_tid(), lane = tid & 63, w = tid >> 6, wm = w >> 1, wn = w & 1, l15 = lane & 15, quad = lane >> 4; \
      const bf16_t* mg = (const bf16_t*)(act + A_MG) + (size_t)r0 * 3072 + (BR) * 1024 + (COL0) + wn * (NTT) * 16; \
      _Pragma("unroll") for (int mt = 0; mt < 4; ++mt) _Pragma("unroll") for (int nt = 0; nt < (NTT); ++nt) { \
          const bf16_t* gp = mg + (size_t)(wm * 64 + mt * 16 + l15) * 3072 + nt * 16 + quad * 4; \
          const u32x2 gw = *(const u32x2*)(gp); \
          f32x4 f = (f32x4){bflo(gw.x), bfhi(gw.x), bflo(gw.y), bfhi(gw.y)}; \
          if ((BR) < 2) { const u32x2 gn = *(const u32x2*)(gp + 1024); \
            f[0] *= __builtin_amdgcn_rcpf(bflo(gn.x)); f[1] *= __builtin_amdgcn_rcpf(bfhi(gn.x)); \
            f[2] *= __builtin_amdgcn_rcpf(bflo(gn.y)); f[3] *= __builtin_amdgcn_rcpf(bfhi(gn.y)); } \
          ACC[mt][nt] *= f; } } while (0)
DI void merge_phase(const Params& p, bool last, unsigned char* lds) {
  unsigned char* act = p.ws + OFF_ACT;
  for (int i_ = 0;; ++i_) {
    int rt, tn;
    if (!unit_order(i_, BG * 8, 8, rt, tn)) break;
    const int tm = (rt / 8) * 9 + (rt & 7);
    const int r0 = tm * 256;
    f32x4 acc[4][4]; zero_acc(acc);
    gemm_tile<true, false>((const bf16_t*)(act + A_GG) + (size_t)r0 * 1024, 1024, (const bf16_t*)(p.ws + OFF_WM + WM_WPA) + (size_t)tn * 128 * 1024, 1024, 1024, lds, acc);
    MERGE_SCALE_T(acc, 4, 0, tn * 128);
    gemm_tile<true, false>((const bf16_t*)(act + A_SQ) + (size_t)r0 * 1024, 1024, (const bf16_t*)(p.ws + OFF_WM + WM_WPB) + (size_t)tn * 128 * 1024, 1024, 1024, lds, acc);
    MERGE_SCALE_T(acc, 4, 1, tn * 128);
    gemm_tile<true, true>((const bf16_t*)(act + A_QF) + (size_t)r0 * 1536, 1536, (const bf16_t*)(p.ws + OFF_WM + WM_WPC) + (size_t)tn * 128 * 1024, 1024, 1024, lds, acc);
    MERGE_SCALE_T(acc, 4, 2, tn * 128);
    stage_rows<4>(acc, lds, (bf16_t*)(act + A_GQK) + (size_t)r0 * 1024 + tn * 128, 1024, 1.0f);
  }
  if (last) return;
  for (int id = blockIdx.x; id < BG * 16; id += gridDim.x) {
    const int tm = (id >> 4) * 9 + 8, t64 = id & 15;
    const int r0 = tm * 256;
    f32x4 acc[4][2];
#pragma unroll
    for (int a_ = 0; a_ < 4; ++a_) { acc[a_][0] = (f32x4){0.f, 0.f, 0.f, 0.f}; acc[a_][1] = (f32x4){0.f, 0.f, 0.f, 0.f}; }
    gemm_tile_n64<false>((const bf16_t*)(act + A_GG) + (size_t)r0 * 1024, 1024, (const bf16_t*)(p.ws + OFF_WM + WM_WPA) + (size_t)t64 * 64 * 1024, 1024, 1024, lds, acc);
    MERGE_SCALE_T(acc, 2, 0, t64 * 64);
    gemm_tile_n64<false>((const bf16_t*)(act + A_SQ) + (size_t)r0 * 1024, 1024, (const bf16_t*)(p.ws + OFF_WM + WM_WPB) + (size_t)t64 * 64 * 1024, 1024, 1024, lds, acc);
    MERGE_SCALE_T(acc, 2, 1, t64 * 64);
    gemm_tile_n64<true>((const bf16_t*)(act + A_QF) + (size_t)r0 * 1536, 1536, (const bf16_t*)(p.ws + OFF_WM + WM_WPC) + (size_t)t64 * 64 * 1024, 1024, 1024, lds, acc);
    MERGE_SCALE_T(acc, 2, 2, t64 * 64);
    stage_rows<2>(acc, lds, (bf16_t*)(act + A_GQK) + (size_t)r0 * 1024 + t64 * 64, 1024, 1.0f);
  }
}
#undef MERGE_SCALE_T

DI void resid_epilogue(const f32x4 (&acc)[4][4], const float* srcp, float* dstp, const float* gate, int wm, int l15, int quad) {
#pragma unroll
  for (int mt = 0; mt < 4; ++mt) {
    const size_t ro = (size_t)(wm * 64 + mt * 16 + l15) * 1024 + quad * 4;
#pragma unroll
    for (int nt = 0; nt < 4; ++nt) {
      const f32x4 xo = *(const f32x4*)(srcp + ro + nt * 16);
      const f32x4 gv = *(const f32x4*)(gate + nt * 16 + quad * 4);
      *(f32x4*)(dstp + ro + nt * 16) = xo + gv * acc[mt][nt];
    }
  }
}

DI void resid_epilogue2(const f32x4 (&acc)[4][2], const float* srcp, float* dstp, const float* gate, int wm, int l15, int quad) {
#pragma unroll
  for (int mt = 0; mt < 4; ++mt) {
    const size_t ro = (size_t)(wm * 64 + mt * 16 + l15) * 1024 + quad * 4;
#pragma unroll
    for (int nt = 0; nt < 2; ++nt) {
      const f32x4 xo = *(const f32x4*)(srcp + ro + nt * 16);
      const f32x4 gv = *(const f32x4*)(gate + nt * 16 + quad * 4);
      *(f32x4*)(dstp + ro + nt * 16) = xo + gv * acc[mt][nt];
    }
  }
}
DI void wo_phase(const Params& p, int l, int g, bool last, unsigned char* lds) {
  unsigned char* act = p.ws + OFF_ACT;
  const float* MOD = (const float*)(p.ws + OFF_MOD);
  float* XC = (float*)(p.ws + OFF_XC);
  for (int i_ = 0;; ++i_) {
    int rt, tn;
    if (!unit_order(i_, BG * 8, 8, rt, tn)) break;
    const int bl = rt >> 3, tt = rt & 7, tm = bl * 9 + tt, b = g * BG + bl;
    const int r0 = tm * 256;
    f32x4 acc[4][4]; zero_acc(acc);
    gemm_tile<true, false>((const bf16_t*)(act + A_GQK) + (size_t)r0 * 1024, 1024, (const bf16_t*)(p.ws + OFF_WM + WM_WO) + (size_t)tn * 128 * 1024, 1024, 1024, lds, acc);
    const int tid = opaque_tid(), lane = tid & 63, w = tid >> 6, wm = w >> 1, wn = w & 1, l15 = lane & 15, quad = lane >> 4;
    const int coff = tn * 128 + wn * 64;
    const size_t base = ((size_t)b * 2048 + tt * 256) * 1024 + coff;
    resid_epilogue(acc, (l == 0 ? p.x : p.out) + base, p.out + base, MOD + (size_t)(l * 9 + b) * 6144 + 2048 + coff, wm, l15, quad);
  }
  if (last) return;
  for (int id = blockIdx.x; id < BG * 16; id += gridDim.x) {
    const int bl = id >> 4, t64 = id & 15, tm = bl * 9 + 8, b = g * BG + bl;
    const int r0 = tm * 256;
    f32x4 acc[4][2];
#pragma unroll
    for (int a_ = 0; a_ < 4; ++a_) { acc[a_][0] = (f32x4){0.f, 0.f, 0.f, 0.f}; acc[a_][1] = (f32x4){0.f, 0.f, 0.f, 0.f}; }
    gemm_tile_n64<false>((const bf16_t*)(act + A_GQK) + (size_t)r0 * 1024, 1024, (const bf16_t*)(p.ws + OFF_WM + WM_WO) + (size_t)t64 * 64 * 1024, 1024, 1024, lds, acc);
    const int tid = opaque_tid(), lane = tid & 63, w = tid >> 6, wm = w >> 1, wn = w & 1, l15 = lane & 15, quad = lane >> 4;
    const int coff = t64 * 64 + wn * 32;
    const size_t base = ((size_t)b * 256) * 1024 + coff;
    resid_epilogue2(acc, (l == 0 ? p.ctx : XC) + base, XC + base, MOD + (size_t)(l * 9 + 8) * 6144 + 2048 + coff, wm, l15, quad);
  }
}

DI void ffnin_epi(const Params& p, const f32x4 (&acc)[4][4], int r0, int tn, unsigned char* lds) {
  unsigned char* act = p.ws + OFF_ACT;
  f32x4 hv[4][2];
#pragma unroll
  for (int mt = 0; mt < 4; ++mt)
#pragma unroll
    for (int np = 0; np < 2; ++np) {
      const f32x4 gte = acc[mt][2 * np], up = acc[mt][2 * np + 1];
#pragma unroll
      for (int i = 0; i < 4; ++i) hv[mt][np][i] = siluf_(gte[i]) * up[i];
    }
  stage_rows<2>(hv, lds, (bf16_t*)(act + F_HID) + (size_t)r0 * 2816 + tn * 64, 2816, 1.0f);
}
DI void ffnin_phase(const Params& p, bool last, unsigned char* lds) {
  unsigned char* act = p.ws + OFF_ACT;
  const int nrt = last ? 64 : 72;
  const int total = nrt * 22, G_ = gridDim.x;
  const int full = (total / G_) * G_;
  for (int i_ = 0; i_ * G_ < full; ++i_) {
    int rt, tp;
    if (!unit_order(i_, nrt, 22, rt, tp)) break;
    const int tm = last ? (rt / 8) * 9 + (rt & 7) : rt;
    const int r0 = tm * 256;
    f32x4 acc0[4][4], acc1[4][4]; zero_acc(acc0); zero_acc(acc1);
    gemm_tile2<true>((const bf16_t*)(act + F_H2) + (size_t)r0 * 1024, 1024, (const bf16_t*)(act + F_WFI) + (size_t)tp * 256 * 1024, 1024, 1024, lds, acc0, acc1);
    ffnin_epi(p, acc0, r0, 2 * tp, lds);
    ffnin_epi(p, acc1, r0, 2 * tp + 1, lds);
  }
  for (int sidx = blockIdx.x; sidx < 2 * (total - full); sidx += G_) {
    int rt, tp;
    if (!unit_of((long)full + (sidx >> 1), nrt, 22, rt, tp)) break;
    const int tm = last ? (rt / 8) * 9 + (rt & 7) : rt;
    const int r0 = tm * 256, tn = 2 * tp + (sidx & 1);
    f32x4 acc[4][4]; zero_acc(acc);
    gemm_tile<true, false>((const bf16_t*)(act + F_H2) + (size_t)r0 * 1024, 1024, (const bf16_t*)(act + F_WFI) + (size_t)tn * 128 * 1024, 1024, 1024, lds, acc);
    ffnin_epi(p, acc, r0, tn, lds);
  }
}

DI void ffnout_epi(const Params& p, const f32x4 (&acc)[4][4], int l, int tm, int tn) {
  const float* MOD = (const float*)(p.ws + OFF_MOD);
  float* XC = (float*)(p.ws + OFF_XC);
  const int tid = opaque_tid(), lane = tid & 63, w = tid >> 6, wm = w >> 1, wn = w & 1, l15 = lane & 15, quad = lane >> 4;
  const int b = tm / 9, tt = tm - b * 9;
  const int coff = tn * 128 + wn * 64;
  if (tt < 8) {
    const size_t base = ((size_t)b * 2048 + tt * 256) * 1024 + coff;
    resid_epilogue(acc, p.out + base, p.out + base, MOD + (size_t)(l * 9 + b) * 6144 + 5120 + coff, wm, l15, quad);
  } else {
    const size_t base = ((size_t)b * 256) * 1024 + coff;
    resid_epilogue(acc, XC + base, XC + base, MOD + (size_t)(l * 9 + 8) * 6144 + 5120 + coff, wm, l15, quad);
  }
}
DI void ffnout_phase(const Params& p, int l, bool last, unsigned char* lds) {
  unsigned char* act = p.ws + OFF_ACT;
  const int nrt = last ? 64 : 72;
  for (int i_ = 0;; ++i_) {
    int rt, tp;
    if (!unit_order(i_, nrt, 4, rt, tp)) break;
    const int tm = last ? (rt / 8) * 9 + (rt & 7) : rt;
    const int r0 = tm * 256;
    f32x4 acc0[4][4], acc1[4][4]; zero_acc(acc0); zero_acc(acc1);
    gemm_tile2<true>((const bf16_t*)(act + F_HID) + (size_t)r0 * 2816, 2816, (const bf16_t*)(act + F_WFO) + (size_t)tp * 256 * 2816, 2816, 2816, lds, acc0, acc1);
    ffnout_epi(p, acc0, l, tm, 2 * tp);
    ffnout_epi(p, acc1, l, tm, 2 * tp + 1);
  }
}

DI void convert_mixer_weights(const Params& p, int l, unsigned char* lds) {
  unsigned char* wm = p.ws + OFF_WM;
  const int tid = opaque_tid(), lane = tid & 63, w = tid >> 6;
  float* wl = (float*)(lds + w * 4352);
  const int total = 13344;
  for (int id = blockIdx.x * 8 + w; id < total; id += gridDim.x * 8) {
    const float* src; int K, N, mode = 0, rem; bf16_t* dst; const float* ks = nullptr;
    if (id < 8160) { src = p.w_in + (size_t)l * 1024 * 8160; K = 1024; N = 8160; dst = (bf16_t*)(wm + WM_WIN); mode = 1; rem = id; }
    else if (id < 8736) { src = p.w_q_up + (size_t)l * 384 * 1536; K = 384; N = 1536; dst = (bf16_t*)(wm + WM_WQU); ks = p.q_norm + l * 384; rem = id - 8160; }
    else if (id < 9248) { src = p.w_kv_up + (size_t)l * 256 * 2048; K = 256; N = 2048; dst = (bf16_t*)(wm + WM_WKVU); ks = p.kv_norm + l * 256; rem = id - 8736; }
    else if (id < 10272) { src = p.w_pa + (size_t)l * 1024 * 1024; K = 1024; N = 1024; dst = (bf16_t*)(wm + WM_WPA); rem = id - 9248; }
    else if (id < 11296) { src = p.w_pb + (size_t)l * 1024 * 1024; K = 1024; N = 1024; dst = (bf16_t*)(wm + WM_WPB); rem = id - 10272; }
    else if (id < 12320) { src = p.w_pc + (size_t)l * 1024 * 1024; K = 1024; N = 1024; dst = (bf16_t*)(wm + WM_WPC); rem = id - 11296; }
    else { src = p.w_o + (size_t)l * 1024 * 1024; K = 1024; N = 1024; dst = (bf16_t*)(wm + WM_WO); rem = id - 12320; }
    convert_wave_tile(src, K, N, dst, mode, ks, rem, wl, lane);
  }
  if (blockIdx.x == 0) { unsigned* z = (unsigned*)(wm + WM_WIN + (size_t)5088 * 1024 * 2); for (int i = tid; i < 32 * 1024 / 2; i += 512) z[i] = 0u; }
  __syncthreads();
}
DI void convert_ffn_weights(const Params& p, int l, unsigned char* lds) {
  unsigned char* act = p.ws + OFF_ACT;
  const int tid = opaque_tid(), lane = tid & 63, w = tid >> 6;
  float* wl = (float*)(lds + w * 4352);
  const int n1 = 16 * 352, total = n1 + 44 * 64;
  for (int id = blockIdx.x * 8 + w; id < total; id += gridDim.x * 8) {
    if (id < n1) convert_wave_tile(p.w_ffn_in + (size_t)l * 1024 * 5632, 1024, 5632, (bf16_t*)(act + F_WFI), 2, nullptr, id, wl, lane);
    else convert_wave_tile(p.w_ffn_out + (size_t)l * 2816 * 1024, 2816, 1024, (bf16_t*)(act + F_WFO), 0, nullptr, id - n1, wl, lane);
  }
  __syncthreads();
}


#define XB_TMO      128
#define XB_XCNT(j)  (256  + 64 * (j))
#define XB_XSUB(j)  (1280 + 64 * (j))
#define XB_XGEN(j)  (2304 + 64 * (j))
#define XB_TOP      3328
#define XB_TOPGEN   3392
#define XCD_BAR_WORDS 3456
#define XB_SPIN_CAP (1u << 18)
DI unsigned xb_ld(unsigned* p)              { return __hip_atomic_load(p, __ATOMIC_RELAXED, __HIP_MEMORY_SCOPE_AGENT); }
DI unsigned xb_add(unsigned* p, unsigned v) { return __hip_atomic_fetch_add(p, v, __ATOMIC_RELAXED, __HIP_MEMORY_SCOPE_AGENT); }
DI unsigned xb_xcc_id() { return (unsigned)__builtin_amdgcn_s_getreg((3 << 11) | 20) & 0xFu; }
#define XB_SPIN(cond, bar) do { unsigned _sp = 0; while (cond) { __builtin_amdgcn_s_sleep(1); \
    if ((++_sp & 255u) == 0u) { if (xb_ld(&(bar)[XB_TMO])) break; if (_sp > XB_SPIN_CAP) { atomicAdd(&(bar)[XB_TMO], 1u); break; } } } } while (0)
struct XcdBarrier { unsigned* bar; unsigned x; volatile LAS unsigned* st; };
DI XcdBarrier xcd_barrier_post(unsigned* bar, volatile LAS unsigned* st) {
  XcdBarrier b; b.bar = bar; b.x = xb_xcc_id(); b.st = st;
  if (threadIdx.x == 0) (void)xb_add(&bar[XB_XCNT(b.x)], 1u);
  return b;
}
DI void xcd_barrier_complete(unsigned* bar, unsigned x, unsigned& nloc, unsigned& nx) {
  const unsigned G = gridDim.x * gridDim.y * gridDim.z;
  unsigned sum, cnt, mine, sp = 0u;
  for (;;) {
    sum = 0u; cnt = 0u; mine = 0u;
#pragma unroll
    for (unsigned j = 0; j < 16; ++j) { const unsigned c = xb_ld(&bar[XB_XCNT(j)]); sum += c; cnt += (c > 0u) ? 1u : 0u; mine = (j == x) ? c : mine; }
    if (sum == G) break;
    __builtin_amdgcn_s_sleep(1);
    if ((++sp & 255u) == 0u) { if (xb_ld(&bar[XB_TMO])) break; if (sp > XB_SPIN_CAP) { atomicAdd(&bar[XB_TMO], 1u); break; } }
  }
  nloc = mine > 0u ? mine : 1u; nx = cnt > 0u ? cnt : 1u;
}
DI void xcd_barrier(const XcdBarrier& b) {
  asm volatile("s_waitcnt vmcnt(0)" ::: "memory");
  __syncthreads();
  if (threadIdx.x == 0) {
    unsigned* bar = b.bar;
    __builtin_amdgcn_s_waitcnt(0);
    unsigned nloc = b.st[0], nx = b.st[1];
    if (nloc == 0u) { xcd_barrier_complete(bar, b.x, nloc, nx); b.st[0] = nloc; b.st[1] = nx; }
    const unsigned old = xb_add(&bar[XB_XSUB(b.x)], 1u);
    const unsigned gen = old / nloc;
    if (old + 1u == (gen + 1u) * nloc) {
      __builtin_amdgcn_fence(__ATOMIC_RELEASE, "agent");
      asm volatile("s_waitcnt vmcnt(0)" ::: "memory");
      const unsigned og = xb_add(&bar[XB_TOP], 1u);
      const unsigned tg = og / nx;
      if (og + 1u == (tg + 1u) * nx) xb_add(&bar[XB_TOPGEN], 1u);
      else XB_SPIN(xb_ld(&bar[XB_TOPGEN]) == tg, bar);
      __builtin_amdgcn_fence(__ATOMIC_ACQUIRE, "agent");
      xb_add(&bar[XB_XGEN(b.x)], 1u);
      asm volatile("s_waitcnt vmcnt(0)" ::: "memory");
    } else {
      XB_SPIN(xb_ld(&bar[XB_XGEN(b.x)]) == gen, bar);
      __builtin_amdgcn_fence(__ATOMIC_ACQUIRE, "agent");
      asm volatile("s_waitcnt vmcnt(0)" ::: "memory");
    }
  }
  __syncthreads();
}

DI void grid_barrier(unsigned* ctr, unsigned& phase) {
  asm volatile("s_waitcnt vmcnt(0)" ::: "memory");
  __syncthreads();
  phase += 1u;
  if (threadIdx.x == 0) {
    __builtin_amdgcn_fence(__ATOMIC_RELEASE, "agent");
    asm volatile("s_waitcnt vmcnt(0)" ::: "memory");
    __hip_atomic_fetch_add(ctr, 1u, __ATOMIC_RELAXED, __HIP_MEMORY_SCOPE_AGENT);
    const unsigned target = phase * gridDim.x;
    unsigned spins = 0;
    while (__hip_atomic_load(ctr, __ATOMIC_RELAXED, __HIP_MEMORY_SCOPE_AGENT) < target) { __builtin_amdgcn_s_sleep(1); if (++spins > (1u << 24)) break; }
    __builtin_amdgcn_fence(__ATOMIC_ACQUIRE, "agent");
    asm volatile("s_waitcnt vmcnt(0)" ::: "memory");
  }
  __syncthreads();
}

__global__ void __launch_bounds__(512) fwd_megakernel(Params p) {
  cg::grid_group grid = cg::this_grid();
  unsigned char* lds = dyn_lds;
  unsigned char* act = p.ws + OFF_ACT;
  unsigned* gbar = (unsigned*)(p.ws + OFF_CTR) + 128;
  unsigned bphase = 0u;
  if (blockIdx.x == 0) { const int t0 = opaque_tid(); if (t0 < 256) ((unsigned*)(p.ws + OFF_CTR))[t0] = 0u;
    for (int i = t0; i < XCD_BAR_WORDS; i += 512) ((unsigned*)(p.ws + OFF_XBAR))[i] = 0u; }
  volatile LAS unsigned* xb_st = (volatile LAS unsigned*)((LAS unsigned char*)dyn_lds + (LDS_BYTES - 32));
  if (threadIdx.x == 0) { xb_st[0] = 0u; xb_st[1] = 0u; }
  grid.sync();
  const XcdBarrier xbar = xcd_barrier_post((unsigned*)(p.ws + OFF_XBAR), xb_st);
  {
    const int tid = opaque_tid(), lane = tid & 63, w = tid >> 6;
    float* sc = (float*)lds;
    float* red = (float*)(lds + 36864);
    float* MOD = (float*)(p.ws + OFF_MOD);
    for (int item = blockIdx.x; item < 192; item += gridDim.x) {
      for (int i = tid; i < 9216; i += 512) { const int b = i >> 10, k = i & 1023; const float v = b < 8 ? p.c[b * 1024 + k] : p.c_ctx[k]; sc[i] = siluf_(v); }
      __syncthreads();
      const int l = item / 96, cb = (item % 96) * 64;
      float a[9];
#pragma unroll
      for (int b = 0; b < 9; ++b) a[b] = 0.f;
      const float* wp = p.w_mod + ((size_t)l * 1024 + w * 128) * 6144 + cb + lane;
#pragma unroll 8
      for (int k = 0; k < 128; ++k) {
        const float wv = wp[(size_t)k * 6144];
#pragma unroll
        for (int b = 0; b < 9; ++b) a[b] += sc[b * 1024 + w * 128 + k] * wv;
      }
#pragma unroll
      for (int b = 0; b < 9; ++b) red[(w * 9 + b) * 64 + lane] = a[b];
      __syncthreads();
      for (int i = tid; i < 576; i += 512) {
        const int b = i >> 6, ln = i & 63;
        float s = 0.f;
        for (int ww = 0; ww < 8; ++ww) s += red[(ww * 9 + b) * 64 + ln];
        MOD[(size_t)(l * 9 + b) * 6144 + cb + ln] = s + p.b_mod[l * 6144 + cb + ln];
      }
      __syncthreads();
    }
    if (blockIdx.x == gridDim.x - 1) {
      float2* rope = (float2*)(p.ws + OFF_ROPE);
      for (int i = tid; i < 1024; i += 512) {
        const int pos = i >> 4, f = i & 15;
        const float inv = powf(10000.0f, -(float)f / 16.0f);
        const float ang = (float)pos * inv;
        rope[i] = make_float2(cosf(ang), sinf(ang));
      }
    }
  }
  for (int l_ = 0; l_ < 2; ++l_) {
    int l = l_; asm volatile("" : "+s"(l));
    const bool last = (l == 1);
    convert_mixer_weights(p, l, lds);
    xcd_barrier(xbar);
    for (int g = 0; g < NGRP; ++g) {
      if (g == 0) {
        { float* rsq = (float*)(p.ws + OFF_RSQ); for (int i = blockIdx.x * 512 + opaque_tid(); i < 2 * R; i += gridDim.x * 512) rsq[i] = 0.f; }
        norm_phase(p, l, 0, 0, BG, l == 0 ? p.x : p.out, l == 0 ? p.ctx : (const float*)(p.ws + OFF_XC), (bf16_t*)(act + A_H), false);
        xcd_barrier(xbar);
      }
      inproj_phase(p, g, lds);
      xcd_barrier(xbar);
      mlaup_phase(p, last, lds);
      xcd_barrier(xbar);
      mixers_phase(p, l, g, last, lds);
      xcd_barrier(xbar);
      glapost_phase(p, l);
      xcd_barrier(xbar);
      merge_phase(p, last, lds);
      xcd_barrier(xbar);
      wo_phase(p, l, g, last, lds);
      if (g == NGRP - 1) { __syncthreads(); convert_ffn_weights(p, l, lds); }
      if (g == 0) {
        { float* rsq = (float*)(p.ws + OFF_RSQ); for (int i = blockIdx.x * 512 + opaque_tid(); i < 2 * R; i += gridDim.x * 512) rsq[i] = 0.f; }
        norm_phase(p, l, 0, BG, BG, l == 0 ? p.x : p.out, l == 0 ? p.ctx : (const float*)(p.ws + OFF_XC), (bf16_t*)(act + A_H), false);
      }
      xcd_barrier(xbar);
    }
    {
      norm_phase(p, l, 1, 0, 8, p.out, (const float*)(p.ws + OFF_XC), (bf16_t*)(act + F_H2), last);
    }
    xcd_barrier(xbar);
    ffnin_phase(p, last, lds);
    xcd_barrier(xbar);
    ffnout_phase(p, l, last, lds);
    xcd_barrier(xbar);
  }
  const int tid = opaque_tid(), lane = tid & 63, w = tid >> 6;
  for (int r = blockIdx.x * 8 + w; r < 16384; r += gridDim.x * 8) {
    float* xp = p.out + (size_t)r * 1024;
    float4 v[4]; float ss = 0.f;
#pragma unroll
    for (int i = 0; i < 4; ++i) { v[i] = *(const float4*)(xp + lane * 4 + 256 * i); ss += v[i].x * v[i].x + v[i].y * v[i].y + v[i].z * v[i].z + v[i].w * v[i].w; }
#pragma unroll
    for (int o = 32; o >= 1; o >>= 1) ss += shx(ss, lane, o);
    const float rstd = rsqrtf(ss * (1.0f / 1024.0f) + 1e-6f);
#pragma unroll
    for (int i = 0; i < 4; ++i) {
      const float4 gn = *(const float4*)(p.final_norm + lane * 4 + 256 * i);
      float4 o; o.x = v[i].x * rstd * gn.x; o.y = v[i].y * rstd * gn.y; o.z = v[i].z * rstd * gn.z; o.w = v[i].w * rstd * gn.w;
      *(float4*)(xp + lane * 4 + 256 * i) = o;
    }
  }
}

extern "C" void kernel_launch(void* const* d_in, const int* in_sizes, int n_in, void* d_out, int out_size, void* d_ws, size_t ws_size,
                              hipStream_t stream) {
  constexpr size_t kDynLds = LDS_BYTES;
  static int grid_blocks = 0;
  if (!grid_blocks) {
    int dev = 0, cus = 0, per_cu = 0;
    hipGetDevice(&dev);
    hipDeviceGetAttribute(&cus, hipDeviceAttributeMultiprocessorCount, dev);
    hipFuncSetAttribute((const void*)fwd_megakernel, hipFuncAttributeMaxDynamicSharedMemorySize, (int)kDynLds);
    hipOccupancyMaxActiveBlocksPerMultiprocessor(&per_cu, fwd_megakernel, 512, kDynLds);
    if (per_cu < 1) per_cu = 1;
    if (per_cu > 1) per_cu = 1;
    grid_blocks = cus * per_cu;
  }
  if (ws_size < WS_NEED) { fprintf(stderr, "workspace too small: %zu < %zu\n", ws_size, (size_t)WS_NEED); }
  Params p{};
  const float** pp = (const float**)&p;
  for (int i = 0; i < 26; ++i) pp[i] = (const float*)d_in[i];
  p.out = (float*)d_out;
  p.ws = (unsigned char*)d_ws;
  void* args[] = {&p};
  hipError_t e = hipLaunchCooperativeKernel((void*)fwd_megakernel, dim3(grid_blocks), dim3(512), args, kDynLds, stream);
  if (e != hipSuccess) fprintf(stderr, "cooperative launch failed: %s (grid %d)\n", hipGetErrorString(e), grid_blocks);
}
```

```cpp
#include <hip/hip_runtime.h>
#include <hip/hip_cooperative_groups.h>
#include <cstdio>
#include <cstdint>
namespace cg = cooperative_groups;
#define DI __device__ __forceinline__
typedef unsigned short bf16_t;
typedef short bf16x8 __attribute__((ext_vector_type(8)));
typedef short s16x4 __attribute__((ext_vector_type(4)));
typedef float f32x4 __attribute__((ext_vector_type(4)));
typedef unsigned u32x2 __attribute__((ext_vector_type(2)));
typedef unsigned u32x4 __attribute__((ext_vector_type(4)));

constexpr int TT = 2304;
constexpr int BG = 4;
constexpr int NGRP = 2;
constexpr int R = BG * TT;
constexpr int RALL = 8 * TT;
constexpr float LOG2E = 1.4426950408889634f;

constexpr size_t OFF_CTR = 0;
constexpr size_t OFF_MOD = 4096;
constexpr size_t OFF_ROPE = OFF_MOD + 2 * 9 * 6144 * 4;
constexpr size_t OFF_RSQ = OFF_ROPE + 64 * 16 * 8;
constexpr size_t OFF_XBAR = OFF_RSQ + (size_t)2 * R * 4;
constexpr size_t OFF_XC = OFF_XBAR + 16384;
constexpr size_t OFF_WM = OFF_XC + (size_t)2048 * 1024 * 4;
constexpr size_t WM_WIN = 0;
constexpr size_t WM_WQU = WM_WIN + (size_t)8192 * 1024 * 2;
constexpr size_t WM_WKVU = WM_WQU + (size_t)1536 * 384 * 2;
constexpr size_t WM_WPA = WM_WKVU + (size_t)2048 * 256 * 2;
constexpr size_t WM_WPB = WM_WPA + (size_t)1024 * 1024 * 2;
constexpr size_t WM_WPC = WM_WPB + (size_t)1024 * 1024 * 2;
constexpr size_t WM_WO = WM_WPC + (size_t)1024 * 1024 * 2;
constexpr size_t WM_SIZE = WM_WO + (size_t)1024 * 1024 * 2;
constexpr size_t OFF_ACT = OFF_WM + WM_SIZE;
constexpr size_t A_H = 0;
constexpr size_t A_GQK = A_H + (size_t)R * 2048;
constexpr size_t A_GVT = A_GQK + (size_t)R * 2048;
constexpr size_t A_GG = A_GVT + (size_t)R * 2048;
constexpr size_t A_GKR = A_GG + (size_t)R * 2048;
constexpr size_t A_SQ = A_GKR + (size_t)R * 128;
constexpr size_t A_SK = A_SQ + (size_t)R * 2048;
constexpr size_t A_SVT = A_SK + (size_t)R * 256;
constexpr size_t A_CQ = A_SVT + (size_t)R * 256;
constexpr size_t A_CKV = A_CQ + (size_t)R * 768;
constexpr size_t A_KR = A_CKV + (size_t)R * 512;
constexpr size_t A_QF = A_KR + (size_t)R * 128;
constexpr size_t A_KN = A_QF + (size_t)R * 3072;
constexpr size_t A_VT = A_KN + (size_t)R * 2048;
constexpr size_t A_MG = A_VT + (size_t)R * 2048;
constexpr size_t A_OB = A_MG + (size_t)R * 6144;
constexpr size_t ACT_SIZE = A_OB + (size_t)R * 2048;
constexpr size_t F_H2 = 0;
constexpr size_t F_HID = F_H2 + (size_t)RALL * 2048;
constexpr size_t F_WFI = F_HID + (size_t)RALL * 5632;
constexpr size_t F_WFO = F_WFI + (size_t)5632 * 1024 * 2;
constexpr size_t WS_NEED = OFF_ACT + ACT_SIZE;

constexpr int LDS_BYTES = 151552;
constexpr int G_BUF = 49152, G_BOFF = 32768, G_EXTRA = 147456;
constexpr int L_QD = 0, L_KI = L_QD + 17408, L_KET = L_KI + 17408, L_VT = L_KET + 18432, L_ST = L_VT + 9216,
              L_WG = L_ST + 17408, L_BG = L_WG + 8192, L_ETOT = L_BG + 512, L_END = L_ETOT + 512;
constexpr int L_ITEM = LDS_BYTES - 16;
static_assert(L_END <= L_ITEM, "lds");

struct Params {
  const float *x, *c, *ctx, *c_ctx, *w_mod, *b_mod, *norm_mix, *w_in, *w_gk_fwd, *b_gk_fwd, *w_gk_bwd, *b_gk_bwd, *gla_norm, *sinks,
      *q_norm, *w_q_up, *kv_norm, *w_kv_up, *w_pa, *w_pb, *w_pc, *w_o, *norm_ffn, *w_ffn_in, *w_ffn_out, *final_norm;
  float* out;
  unsigned char* ws;
};

extern __shared__ __attribute__((aligned(16))) unsigned char dyn_lds[];

typedef __bf16 bf16x2_t __attribute__((ext_vector_type(2)));
typedef float f32x2_t __attribute__((ext_vector_type(2)));
DI unsigned pk2(float lo, float hi) { f32x2_t f = {lo, hi}; bf16x2_t v = __builtin_convertvector(f, bf16x2_t); return __builtin_bit_cast(unsigned, v); }
DI float bflo(unsigned w) { return __uint_as_float(w << 16); }
DI float bfhi(unsigned w) { return __uint_as_float(w & 0xffff0000u); }
DI float bf2f(bf16_t v) { return __uint_as_float(((unsigned)v) << 16); }
DI bf16_t f2bf(float x) { return (bf16_t)(pk2(x, 0.f) & 0xffffu); }
DI u32x2 pk4(f32x4 v) { u32x2 r; r.x = pk2(v[0], v[1]); r.y = pk2(v[2], v[3]); return r; }
DI float sigmoidf_(float x) { return __builtin_amdgcn_rcpf(1.0f + __builtin_amdgcn_exp2f(-1.4426950408889634f * x)); }
DI float siluf_(float x) { return x * __builtin_amdgcn_rcpf(1.0f + __builtin_amdgcn_exp2f(-1.4426950408889634f * x)); }
DI int opaque_tid() { int t = threadIdx.x; asm volatile("" : "+v"(t)); return t; }

template <int CTRL, int ROWMASK, bool BOUND>
DI float dpp_move(float x) { return __builtin_bit_cast(float, __builtin_amdgcn_update_dpp(0, __builtin_bit_cast(int, x), CTRL, ROWMASK, 0xF, BOUND)); }
DI float wave_incl_scan(float x) {
  x += dpp_move<0x111, 0xF, true>(x);
  x += dpp_move<0x112, 0xF, true>(x);
  x += dpp_move<0x114, 0xF, true>(x);
  x += dpp_move<0x118, 0xF, true>(x);
  x += dpp_move<0x142, 0xA, false>(x);
  x += dpp_move<0x143, 0xC, false>(x);
  return x;
}
DI float shx(float v, int lane, int m) { return __builtin_bit_cast(float, __builtin_amdgcn_ds_bpermute((lane ^ m) << 2, __builtin_bit_cast(int, v))); }
#define LDS_BARRIER() do { asm volatile("s_waitcnt lgkmcnt(0)" ::: "memory"); __builtin_amdgcn_s_barrier(); asm volatile("" ::: "memory"); } while (0)
#define MFMA16(a, b, c) __builtin_amdgcn_mfma_f32_16x16x32_bf16((a), (b), (c), 0, 0, 0)

#define LAS __attribute__((address_space(3)))
template <bool SWAP, bool ASEG, bool DEEP = true>
DI void gemm_tile(const bf16_t* __restrict__ A, int lda, const bf16_t* __restrict__ Bt, int ldb, int K, unsigned char* lds,
                  f32x4 (&acc)[4][4]) {
  const int tid = opaque_tid(), lane = tid & 63, w = tid >> 6, wm = w >> 1, wn = w & 1, l15 = lane & 15, quad = lane >> 4;
  const int lrow = tid >> 3;
  const int lchs = (tid & 7) ^ ((lrow >> 1) & 7);
  const int nk = K >> 6;
  const unsigned voffA = (unsigned)(lrow * lda + lchs * 8) * 2u, voffB = (unsigned)(lrow * ldb + lchs * 8) * 2u;
  const char* Ab = (const char*)A; const char* Bb = (const char*)Bt;
  LAS unsigned char* l3 = (LAS unsigned char*)dyn_lds;
  const int sw0 = ((quad ^ (l15 >> 1)) * 16), sw1 = (((4 + quad) ^ (l15 >> 1)) * 16);
  const int arow = (wm * 64 + l15) * 128, brow = G_BOFF + (wn * 64 + l15) * 128;
#define GT_DMA(KT, ST) do { const int ku_ = ASEG ? (((KT) >> 1) * 192 + ((KT) & 1) * 64) : (KT) * 64; \
    _Pragma("unroll") for (int i = 0; i < 4; ++i) __builtin_amdgcn_global_load_lds((const unsigned*)(Ab + (size_t)(64 * i * lda + ku_) * 2 + voffA), \
        (LAS unsigned*)(l3 + (ST) * G_BUF + i * 8192 + w * 1024), 16, 0, 0); \
    _Pragma("unroll") for (int i = 0; i < 2; ++i) __builtin_amdgcn_global_load_lds((const unsigned*)(Bb + (size_t)(64 * i * ldb + (KT) * 64) * 2 + voffB), \
        (LAS unsigned*)(l3 + (ST) * G_BUF + G_BOFF + i * 8192 + w * 1024), 16, 0, 0); } while (0)
#define GT_READ(AF, BF, ST, KS) do { const unsigned char* base_ = lds + (ST) * G_BUF + ((KS) ? sw1 : sw0); \
    _Pragma("unroll") for (int mt = 0; mt < 4; ++mt) AF[mt] = *(const bf16x8*)(base_ + arow + mt * 16 * 128); \
    _Pragma("unroll") for (int nt = 0; nt < 4; ++nt) BF[nt] = *(const bf16x8*)(base_ + brow + nt * 16 * 128); } while (0)
#define GT_MMA(AF, BF) do { _Pragma("unroll") for (int mt = 0; mt < 4; ++mt) _Pragma("unroll") for (int nt = 0; nt < 4; ++nt) \
      acc[mt][nt] = SWAP ? MFMA16(BF[nt], AF[mt], acc[mt][nt]) : MFMA16(AF[mt], BF[nt], acc[mt][nt]); } while (0)
  bf16x8 fa0[4], fb0[4], fa1[4], fb1[4];
  GT_DMA(0, 0);
  GT_DMA(1, 1);
  asm volatile("s_waitcnt vmcnt(6)" ::: "memory");
  LDS_BARRIER();
  int st = 0;
  for (int kt = 0; kt < nk; ++kt) {
    const bool more2 = (kt + 2 < nk);
    if (more2) { const int s2 = st == 0 ? 2 : st - 1; GT_DMA(kt + 2, s2); }
    GT_READ(fa0, fb0, st, 0);
    GT_READ(fa1, fb1, st, 1);
    GT_MMA(fa0, fb0);
    GT_MMA(fa1, fb1);
    if (more2) asm volatile("s_waitcnt vmcnt(6)" ::: "memory"); else asm volatile("s_waitcnt vmcnt(0)" ::: "memory");
    LDS_BARRIER();
    st = st == 2 ? 0 : st + 1;
  }
#undef GT_DMA
#undef GT_READ
#undef GT_MMA
}
template <bool ASEG>
DI void gemm_tile_n64(const bf16_t* __restrict__ A, int lda, const bf16_t* __restrict__ Bt, int ldb, int K, unsigned char* lds,
                      f32x4 (&acc)[4][2]) {
  const int tid = opaque_tid(), lane = tid & 63, w = tid >> 6, wm = w >> 1, wn = w & 1, l15 = lane & 15, quad = lane >> 4;
  const int lrow = tid >> 3;
  const int lchs = (tid & 7) ^ ((lrow >> 1) & 7);
  const int nk = K >> 6;
  const unsigned voffA = (unsigned)(lrow * lda + lchs * 8) * 2u, voffB = (unsigned)(lrow * ldb + lchs * 8) * 2u;
  const char* Ab = (const char*)A; const char* Bb = (const char*)Bt;
  LAS unsigned char* l3 = (LAS unsigned char*)dyn_lds;
  const int sw0 = ((quad ^ (l15 >> 1)) * 16), sw1 = (((4 + quad) ^ (l15 >> 1)) * 16);
  const int arow = (wm * 64 + l15) * 128, brow = G_BOFF + (wn * 32 + l15) * 128;
#define GN_DMA(KT, ST) do { const int ku_ = ASEG ? (((KT) >> 1) * 192 + ((KT) & 1) * 64) : (KT) * 64; \
    _Pragma("unroll") for (int i = 0; i < 4; ++i) __builtin_amdgcn_global_load_lds((const unsigned*)(Ab + (size_t)(64 * i * lda + ku_) * 2 + voffA), \
        (LAS unsigned*)(l3 + (ST) * G_BUF + i * 8192 + w * 1024), 16, 0, 0); \
    __builtin_amdgcn_global_load_lds((const unsigned*)(Bb + (size_t)((KT) * 64) * 2 + voffB), (LAS unsigned*)(l3 + (ST) * G_BUF + G_BOFF + w * 1024), 16, 0, 0); } while (0)
  GN_DMA(0, 0);
  GN_DMA(1, 1);
  asm volatile("s_waitcnt vmcnt(5)" ::: "memory");
  LDS_BARRIER();
  int st = 0;
  for (int kt = 0; kt < nk; ++kt) {
    const bool more2 = (kt + 2 < nk);
    if (more2) { const int s2 = st == 0 ? 2 : st - 1; GN_DMA(kt + 2, s2); }
#pragma unroll
    for (int ks = 0; ks < 2; ++ks) {
      const unsigned char* base_ = lds + st * G_BUF + (ks ? sw1 : sw0);
      bf16x8 fa[4], fb[2];
#pragma unroll
      for (int mt = 0; mt < 4; ++mt) fa[mt] = *(const bf16x8*)(base_ + arow + mt * 16 * 128);
#pragma unroll
      for (int nt = 0; nt < 2; ++nt) fb[nt] = *(const bf16x8*)(base_ + brow + nt * 16 * 128);
#pragma unroll
      for (int mt = 0; mt < 4; ++mt)
#pragma unroll
        for (int nt = 0; nt < 2; ++nt) acc[mt][nt] = MFMA16(fb[nt], fa[mt], acc[mt][nt]);
    }
    if (more2) asm volatile("s_waitcnt vmcnt(5)" ::: "memory"); else asm volatile("s_waitcnt vmcnt(0)" ::: "memory");
    LDS_BARRIER();
    st = st == 2 ? 0 : st + 1;
  }
#undef GN_DMA
}
DI void zero_acc(f32x4 (&acc)[4][4]) {
#pragma unroll
  for (int a = 0; a < 4; ++a)
#pragma unroll
    for (int b = 0; b < 4; ++b) acc[a][b] = (f32x4){0.f, 0.f, 0.f, 0.f};
}

template <bool SWAP>
DI void gemm_tile2(const bf16_t* __restrict__ A, int lda, const bf16_t* __restrict__ Bt, int ldb, int K, unsigned char* lds,
                   f32x4 (&acc0)[4][4], f32x4 (&acc1)[4][4]) {
  const int tid = opaque_tid(), lane = tid & 63, w = tid >> 6, wm = w >> 1, wn = w & 1, l15 = lane & 15, quad = lane >> 4;
  const int lrow = tid >> 3;
  const int lchs = (tid & 7) ^ ((lrow >> 1) & 7);
  const int nk = K >> 6;
  const unsigned voffA = (unsigned)(lrow * lda + lchs * 8) * 2u, voffB = (unsigned)(lrow * ldb + lchs * 8) * 2u;
  const char* Ab = (const char*)A; const char* Bb = (const char*)Bt;
  LAS unsigned char* l3 = (LAS unsigned char*)dyn_lds;
  const int sw0 = ((quad ^ (l15 >> 1)) * 16), sw1 = (((4 + quad) ^ (l15 >> 1)) * 16);
  const int arow = (wm * 64 + l15) * 128, brow = 32768 + (wn * 64 + l15) * 128;
  constexpr int SB = 65536;
#define G2_DMA(KT, ST) do { \
    _Pragma("unroll") for (int i = 0; i < 4; ++i) __builtin_amdgcn_global_load_lds((const unsigned*)(Ab + (size_t)(64 * i * lda + (KT) * 64) * 2 + voffA), \
        (LAS unsigned*)(l3 + (ST) * SB + i * 8192 + w * 1024), 16, 0, 0); \
    _Pragma("unroll") for (int i = 0; i < 4; ++i) __builtin_amdgcn_global_load_lds((const unsigned*)(Bb + (size_t)(64 * i * ldb + (KT) * 64) * 2 + voffB), \
        (LAS unsigned*)(l3 + (ST) * SB + 32768 + i * 8192 + w * 1024), 16, 0, 0); } while (0)
  G2_DMA(0, 0);
  asm volatile("s_waitcnt vmcnt(0)" ::: "memory");
  LDS_BARRIER();
  for (int kt = 0; kt < nk; ++kt) {
    const int st = kt & 1;
    if (kt + 1 < nk) G2_DMA(kt + 1, st ^ 1);
#pragma unroll
    for (int ks = 0; ks < 2; ++ks) {
      const unsigned char* base_ = lds + st * SB + (ks ? sw1 : sw0);
      bf16x8 fa[4], fb0[4], fb1[4];
#pragma unroll
      for (int mt = 0; mt < 4; ++mt) fa[mt] = *(const bf16x8*)(base_ + arow + mt * 16 * 128);
#pragma unroll
      for (int nt = 0; nt < 4; ++nt) fb0[nt] = *(const bf16x8*)(base_ + brow + nt * 16 * 128);
#pragma unroll
      for (int nt = 0; nt < 4; ++nt) fb1[nt] = *(const bf16x8*)(base_ + brow + 128 * 128 + nt * 16 * 128);
#pragma unroll
      for (int mt = 0; mt < 4; ++mt)
#pragma unroll
        for (int nt = 0; nt < 4; ++nt) acc0[mt][nt] = SWAP ? MFMA16(fb0[nt], fa[mt], acc0[mt][nt]) : MFMA16(fa[mt], fb0[nt], acc0[mt][nt]);
#pragma unroll
      for (int mt = 0; mt < 4; ++mt)
#pragma unroll
        for (int nt = 0; nt < 4; ++nt) acc1[mt][nt] = SWAP ? MFMA16(fb1[nt], fa[mt], acc1[mt][nt]) : MFMA16(fa[mt], fb1[nt], acc1[mt][nt]);
    }
    asm volatile("s_waitcnt vmcnt(0)" ::: "memory");
    LDS_BARRIER();
  }
#undef G2_DMA
}


DI bool unit_of(long L, int nM, int nN, int& pm, int& pn);
DI bool unit_order(int i, int nM, int nN, int& pm, int& pn) { return unit_of((long)i * gridDim.x + blockIdx.x, nM, nN, pm, pn); }
DI bool unit_of(long L, int nM, int nN, int& pm, int& pn) {
  const int nwg = nM * nN;
  if (L >= nwg) return false;
  int wgid = (int)L;
  { const int q = nwg / 8, r = nwg % 8, xcd = wgid % 8, off = wgid / 8; wgid = (xcd < r ? xcd * (q + 1) : r * (q + 1) + (xcd - r) * q) + off; }
  const int nig = 8 * nN, gid = wgid / nig, fm = gid * 8, gsz = (nM - fm) < 8 ? (nM - fm) : 8;
  pm = fm + ((wgid % nig) % gsz); pn = (wgid % nig) / gsz;
  return true;
}

DI int colmap(int mode, int n) {
  if (mode == 1) { if (n < 3072) return n; if (n < 3104) return n + 1984; if (n < 5088) return n - 32; return n + 32; }
  if (mode == 3) { return ((n >> 7) & 1) * 1024 + (n >> 8) * 128 + (n & 127); }
  if (mode == 2) { if (n < 2816) return (n >> 4) * 32 + (n & 15); const int j = n - 2816; return (j >> 4) * 32 + 16 + (j & 15); }
  return n;
}
DI void convert_wave_tile(const float* __restrict__ src, int K, int N, bf16_t* __restrict__ dst, int mode, const float* __restrict__ kscale,
                          int tile, float* wl, int lane) {
  const int ntn = N >> 4;
  const int tk = tile / ntn, tn = tile - tk * ntn;
  const int k0 = tk * 64, n0 = tn * 16;
  const float* sp = src + (size_t)(k0 + lane) * N + n0;
  const float4 v0 = *(const float4*)(sp), v1 = *(const float4*)(sp + 4), v2 = *(const float4*)(sp + 8), v3 = *(const float4*)(sp + 12);
  const float sc = kscale ? kscale[k0 + lane] : 1.0f;
  float* wr = wl + lane * 17;
  wr[0] = v0.x * sc; wr[1] = v0.y * sc; wr[2] = v0.z * sc; wr[3] = v0.w * sc; wr[4] = v1.x * sc; wr[5] = v1.y * sc; wr[6] = v1.z * sc; wr[7] = v1.w * sc;
  wr[8] = v2.x * sc; wr[9] = v2.y * sc; wr[10] = v2.z * sc; wr[11] = v2.w * sc; wr[12] = v3.x * sc; wr[13] = v3.y * sc; wr[14] = v3.z * sc; wr[15] = v3.w * sc;
  __builtin_amdgcn_fence(__ATOMIC_RELEASE, "wavefront");
  __builtin_amdgcn_wave_barrier();
  __builtin_amdgcn_fence(__ATOMIC_ACQUIRE, "wavefront");
  const int n = lane >> 2, kq = (lane & 3) * 16;
  const int np = colmap(mode, n0 + n);
  u32x4 o0, o1;
#pragma unroll
  for (int j = 0; j < 4; ++j) { o0[j] = pk2(wl[(kq + 2 * j) * 17 + n], wl[(kq + 2 * j + 1) * 17 + n]); o1[j] = pk2(wl[(kq + 8 + 2 * j) * 17 + n], wl[(kq + 9 + 2 * j) * 17 + n]); }
  bf16_t* dp = dst + (size_t)np * K + k0 + kq;
  *(u32x4*)(dp) = o0; *(u32x4*)(dp + 8) = o1;
  __builtin_amdgcn_fence(__ATOMIC_RELEASE, "wavefront");
  __builtin_amdgcn_wave_barrier();
  __builtin_amdgcn_fence(__ATOMIC_ACQUIRE, "wavefront");
}

DI void norm_phase(const Params& p, int l, int which, int b0, int nb, const float* xsrc, const float* csrc, bf16_t* H, bool skipctx) {
  const int tid = opaque_tid(), lane = tid & 63, w = tid >> 6;
  const float* MOD = (const float*)(p.ws + OFF_MOD);
  const float* gain = (which ? p.norm_ffn : p.norm_mix) + l * 1024;
  const int rows = nb * TT;
  for (int r = blockIdx.x * 8 + w; r < rows; r += gridDim.x * 8) {
    const int bl = r / TT, t = r - bl * TT, b = b0 + bl;
    if (t >= 2048 && skipctx) continue;
    const float* src = (t < 2048) ? xsrc + ((size_t)b * 2048 + t) * 1024 : csrc + ((size_t)b * 256 + (t - 2048)) * 1024;
    const float* mrow = MOD + (size_t)(l * 9 + (t < 2048 ? b : 8)) * 6144 + which * 3072;
    float4 v[4]; float ss = 0.f;
#pragma unroll
    for (int i = 0; i < 4; ++i) { v[i] = *(const float4*)(src + lane * 4 + 256 * i); ss += v[i].x * v[i].x + v[i].y * v[i].y + v[i].z * v[i].z + v[i].w * v[i].w; }
#pragma unroll
    for (int o = 32; o >= 1; o >>= 1) ss += shx(ss, lane, o);
    const float rstd = rsqrtf(ss * (1.0f / 1024.0f) + 1e-6f);
#pragma unroll
    for (int i = 0; i < 4; ++i) {
      const int col = lane * 4 + 256 * i;
      const float4 g = *(const float4*)(gain + col), sh = *(const float4*)(mrow + col), sc = *(const float4*)(mrow + 1024 + col);
      f32x4 o;
      o[0] = v[i].x * rstd * g.x * (1.f + sc.x) + sh.x; o[1] = v[i].y * rstd * g.y * (1.f + sc.y) + sh.y;
      o[2] = v[i].z * rstd * g.z * (1.f + sc.z) + sh.z; o[3] = v[i].w * rstd * g.w * (1.f + sc.w) + sh.w;
      *(u32x2*)(H + (size_t)r * 1024 + col) = pk4(o);
    }
  }
}

DI void rope_acc(f32x4 (&acc)[4][4], const float2* __restrict__ rope, int t0  , int l15, int quad) {
#pragma unroll
  for (int mt = 0; mt < 4; ++mt) {
    const int t = t0 + mt * 16 + l15;
    const int prow = t >> 6, pcol = t & 63;
    const float4* rpr = (const float4*)(rope + prow * 16 + quad * 4);
    const float4* rpc = (const float4*)(rope + pcol * 16 + quad * 4);
    const float4 r01 = rpr[0], r23 = rpr[1], c01 = rpc[0], c23 = rpc[1];
#pragma unroll
    for (int i = 0; i < 4; ++i) {
      const float2 cr = i == 0 ? make_float2(r01.x, r01.y) : i == 1 ? make_float2(r01.z, r01.w) : i == 2 ? make_float2(r23.x, r23.y) : make_float2(r23.z, r23.w);
      const float2 cc = i == 0 ? make_float2(c01.x, c01.y) : i == 1 ? make_float2(c01.z, c01.w) : i == 2 ? make_float2(c23.x, c23.y) : make_float2(c23.z, c23.w);
      const float a1 = acc[mt][0][i], a2 = acc[mt][1][i];
      acc[mt][0][i] = a1 * cr.x - a2 * cr.y; acc[mt][1][i] = a2 * cr.x + a1 * cr.y;
      const float b1 = acc[mt][2][i], b2 = acc[mt][3][i];
      acc[mt][2][i] = b1 * cc.x - b2 * cc.y; acc[mt][3][i] = b2 * cc.x + b1 * cc.y;
    }
    asm volatile("" ::: "memory");
  }
}
DI void store_rows_direct(const f32x4 (&acc)[4][4], bf16_t* dst, int ld, int wm, int l15, int quad, float scale) {
#pragma unroll
  for (int mt = 0; mt < 4; ++mt) {
    bf16_t* rp = dst + (size_t)(wm * 64 + mt * 16 + l15) * ld + quad * 4;
#pragma unroll
    for (int nt = 0; nt < 4; ++nt) *(u32x2*)(rp + nt * 16) = pk4(acc[mt][nt] * scale);
  }
}
template <int NT>
DI void stage_rows(const f32x4 (&v)[4][NT], unsigned char* lds, bf16_t* dst, int ld, float scale) {
  const int tid = opaque_tid(), lane = tid & 63, w = tid >> 6, wm = w >> 1, wn = w & 1, l15 = lane & 15, quad = lane >> 4;
  constexpr int NC = NT * 32, RS = (NC + 8) * 2, CH = NC / 8, PER = (256 * CH) / 512;
#pragma unroll
  for (int mt = 0; mt < 4; ++mt)
#pragma unroll
    for (int nt = 0; nt < NT; ++nt)
      *(u32x2*)(lds + (wm * 64 + mt * 16 + l15) * RS + (wn * NT * 16 + nt * 16 + quad * 4) * 2) = pk4(v[mt][nt] * scale);
  LDS_BARRIER();
#pragma unroll
  for (int i = 0; i < PER; ++i) {
    const int id = tid + 512 * i, row = id / CH, ch = id % CH;
    const u32x4 x = *(const u32x4*)(lds + row * RS + ch * 16);
    *(u32x4*)(dst + (size_t)row * ld + ch * 8) = x;
  }
  LDS_BARRIER();
}
DI void stage_cols(const f32x4 (&v)[4][4], unsigned char* lds, bf16_t* dst) {
  const int tid = opaque_tid(), lane = tid & 63, w = tid >> 6, wm = w >> 1, wn = w & 1, l15 = lane & 15, quad = lane >> 4;
#pragma unroll
  for (int mt = 0; mt < 4; ++mt)
#pragma unroll
    for (int nt = 0; nt < 4; ++nt)
      *(u32x2*)(lds + (wn * 64 + nt * 16 + l15) * 528 + (wm * 64 + mt * 16 + quad * 4) * 2) = pk4(v[mt][nt]);
  LDS_BARRIER();
#pragma unroll
  for (int i = 0; i < 8; ++i) {
    const int id = tid + 512 * i, row = id >> 5, ch = id & 31;
    const u32x4 x = *(const u32x4*)(lds + row * 528 + ch * 16);
    *(u32x4*)(dst + (size_t)row * TT + ch * 8) = x;
  }
  LDS_BARRIER();
}

DI void inproj_epi(const Params& p, f32x4 (&acc)[4][4], int tm, int tn, unsigned char* lds) {
  unsigned char* act = p.ws + OFF_ACT;
  const float2* rope = (const float2*)(p.ws + OFF_ROPE);
  const int bl = tm / 9, tt = tm - bl * 9;
  const bool latent = tt < 8;
  const int r0 = tm * 256, t0 = tt * 256;
  {
    const int tid = opaque_tid(), lane = tid & 63, w = tid >> 6, wm = w >> 1, wn = w & 1, l15 = lane & 15, quad = lane >> 4;
    const int wt0 = t0 + wm * 64;
    if (tn < 4) {
      stage_rows<4>(acc, lds, (bf16_t*)(act + A_GQK) + (size_t)r0 * 1024 + tn * 128, 1024, 0.08838834764831845f);
    } else if (tn < 8) {
      stage_rows<4>(acc, lds, (bf16_t*)(act + A_GQK) + (size_t)r0 * 1024 + 512 + (tn - 4) * 128, 1024, 1.0f);
    } else if (tn < 16) {
      stage_cols(acc, lds, (bf16_t*)(act + A_GVT) + ((size_t)bl * 1024 + (tn - 8) * 128) * TT + t0);
    } else if (tn < 24) {
      stage_rows<4>(acc, lds, (bf16_t*)(act + A_GG) + (size_t)r0 * 1024 + (tn - 16) * 128, 1024, 1.0f);
    } else if (tn < 32) {
      if (latent) rope_acc(acc, rope, wt0, l15, quad);
      stage_rows<4>(acc, lds, (bf16_t*)(act + A_SQ) + (size_t)r0 * 1024 + (tn - 24) * 128, 1024, 0.125f * LOG2E);
    } else if (tn == 32) {
      if (latent) rope_acc(acc, rope, wt0, l15, quad);
      stage_rows<4>(acc, lds, (bf16_t*)(act + A_SK) + (size_t)r0 * 128, 128, 1.0f);
    } else if (tn == 33) {
      stage_cols(acc, lds, (bf16_t*)(act + A_SVT) + ((size_t)bl * 128) * TT + t0);
    } else if (tn < 39) {
      float* rsq = (float*)(p.ws + OFF_RSQ) + (tn < 37 ? 0 : R) + r0;
#pragma unroll
      for (int mt = 0; mt < 4; ++mt) {
        float ss = 0.f;
#pragma unroll
        for (int nt = 0; nt < 4; ++nt) { const f32x4 v = acc[mt][nt]; ss += v[0] * v[0] + v[1] * v[1] + v[2] * v[2] + v[3] * v[3]; }
        ss += shx(ss, lane, 16); ss += shx(ss, lane, 32);
        if (quad == 0) atomicAdd(rsq + wm * 64 + mt * 16 + l15, ss);
      }
      if (tn < 37) stage_rows<4>(acc, lds, (bf16_t*)(act + A_CQ) + (size_t)r0 * 384 + (tn - 34) * 128, 384, 1.0f);
      else stage_rows<4>(acc, lds, (bf16_t*)(act + A_CKV) + (size_t)r0 * 256 + (tn - 37) * 128, 256, 1.0f);
    } else if (tn == 39) {
      if (wn == 0) {
        if (latent) rope_acc(acc, rope, wt0, l15, quad);
        store_rows_direct(acc, (bf16_t*)(act + A_KR) + (size_t)r0 * 64, 64, wm, l15, quad, 1.0f);
      } else {
        float* gkr = (float*)(act + A_GKR);
#pragma unroll
        for (int mt = 0; mt < 4; ++mt)
#pragma unroll
          for (int nt = 0; nt < 2; ++nt)
            *(f32x4*)(gkr + (size_t)(r0 + wm * 64 + mt * 16 + l15) * 32 + nt * 16 + quad * 4) = acc[mt][nt];
      }
    } else {
#pragma unroll
      for (int mt = 0; mt < 4; ++mt)
#pragma unroll
        for (int nt = 0; nt < 4; ++nt) {
          f32x4 v = acc[mt][nt];
          v[0] = fmaxf(sigmoidf_(v[0]), 1e-6f); v[1] = fmaxf(sigmoidf_(v[1]), 1e-6f); v[2] = fmaxf(sigmoidf_(v[2]), 1e-6f); v[3] = fmaxf(sigmoidf_(v[3]), 1e-6f);
          acc[mt][nt] = v;
        }
      stage_rows<4>(acc, lds, (bf16_t*)(act + A_MG) + (size_t)r0 * 3072 + (tn - 40) * 128, 3072, 1.0f);
    }
  }
}
DI void inproj_phase(const Params& p, int g, unsigned char* lds) {
  unsigned char* act = p.ws + OFF_ACT;
  const bf16_t* H = (const bf16_t*)(act + A_H);
  const bf16_t* W = (const bf16_t*)(p.ws + OFF_WM + WM_WIN);
  const int nunits = (R / 256) * 33;
  (void)nunits;
  for (int i_ = 0;; ++i_) {
    int tm, u;
    if (!unit_order(i_, R / 256, 33, tm, u)) break;
    const int r0 = tm * 256;
    if (u < 31) {
      const int tn0 = 2 * (u < 16 ? u : u + 1);
      f32x4 acc0[4][4], acc1[4][4]; zero_acc(acc0); zero_acc(acc1);
      if (tn0 >= 8 && tn0 < 16) gemm_tile2<false>(H + (size_t)r0 * 1024, 1024, W + (size_t)tn0 * 128 * 1024, 1024, 1024, lds, acc0, acc1);
      else gemm_tile2<true>(H + (size_t)r0 * 1024, 1024, W + (size_t)tn0 * 128 * 1024, 1024, 1024, lds, acc0, acc1);
      inproj_epi(p, acc0, tm, tn0, lds);
      inproj_epi(p, acc1, tm, tn0 + 1, lds);
    } else {
      const int tn = u + 1;
      f32x4 acc[4][4]; zero_acc(acc);
      if (tn == 33) gemm_tile<false, false>(H + (size_t)r0 * 1024, 1024, W + (size_t)tn * 128 * 1024, 1024, 1024, lds, acc);
      else gemm_tile<true, false>(H + (size_t)r0 * 1024, 1024, W + (size_t)tn * 128 * 1024, 1024, 1024, lds, acc);
      inproj_epi(p, acc, tm, tn, lds);
    }
  }
}

template <int K>
DI void row_rstd(const bf16_t* __restrict__ A, float* rs, int tid) {
  const int row = tid >> 1, half = tid & 1;
  const bf16_t* ap = A + (size_t)row * K + half * (K / 2);
  float ss = 0.f;
#pragma unroll 4
  for (int c = 0; c < K / 16; ++c) {
    const u32x4 v = *(const u32x4*)(ap + c * 8);
#pragma unroll
    for (int j = 0; j < 4; ++j) { const float a = bflo(v[j]), b = bfhi(v[j]); ss += a * a + b * b; }
  }
  ss += shx(ss, tid & 63, 1);
  if (half == 0) rs[row] = rsqrtf(ss / (float)K + 1e-6f);
}
DI void mlaup_phase(const Params& p, bool last, unsigned char* lds) {
  unsigned char* act = p.ws + OFF_ACT;
  const float2* rope = (const float2*)(p.ws + OFF_ROPE);
  const float* rsq_q = (const float*)(p.ws + OFF_RSQ);
  const float* rsq_kv = rsq_q + R;
  const int nrt_q = last ? BG * 8 : BG * 9;
  const int nq2 = nrt_q * 6, nk2 = (R / 256) * 4;
  const int G_ = gridDim.x, b_ = blockIdx.x;
  for (int id = b_; id < nq2; id += G_) {
    const int rt = id / 6, tp = id - rt * 6;
    const int tm = last ? (rt / 8) * 9 + (rt & 7) : rt;
    const int bl = tm / 9, tt = tm - bl * 9;
    const bool latent = tt < 8;
    const int r0 = tm * 256, t0 = tt * 256;
    f32x4 acc0[4][4], acc1[4][4]; zero_acc(acc0); zero_acc(acc1);
    gemm_tile2<true>((const bf16_t*)(act + A_CQ) + (size_t)r0 * 384, 384, (const bf16_t*)(p.ws + OFF_WM + WM_WQU) + (size_t)tp * 256 * 384, 384, 384, lds, acc0, acc1);
#define QUP_EPI(ACC, TN) do { \
      const int tid = opaque_tid(), lane = tid & 63, w = tid >> 6, wm = w >> 1, wn = w & 1, l15 = lane & 15, quad = lane >> 4; \
      const float sc = 0.07216878364870322f * LOG2E; \
      _Pragma("unroll") for (int mt = 0; mt < 4; ++mt) { const float rv = rsqrtf(rsq_q[r0 + wm * 64 + mt * 16 + l15] * (1.0f / 384.0f) + 1e-6f) * sc; \
        _Pragma("unroll") for (int nt = 0; nt < 4; ++nt) ACC[mt][nt] *= rv; } \
      const int g64 = (TN) * 2 + wn; \
      if ((g64 % 3) == 2 && latent) rope_acc(ACC, rope, t0 + wm * 64, l15, quad); \
      stage_rows<4>(ACC, lds, (bf16_t*)(act + A_QF) + (size_t)r0 * 1536 + (TN) * 128, 1536, 1.0f); } while (0)
    QUP_EPI(acc0, 2 * tp);
    QUP_EPI(acc1, 2 * tp + 1);
#undef QUP_EPI
  }
  for (int gid = b_ + ((nq2 - b_ + G_ - 1) / G_) * G_; gid < nq2 + nk2; gid += G_) {
    const int id = gid - nq2;
    const int tm = id >> 2, tp = id & 3;
    const int r0 = tm * 256;
    f32x4 acc0[4][4], acc1[4][4]; zero_acc(acc0); zero_acc(acc1);
    gemm_tile2<true>((const bf16_t*)(act + A_CKV) + (size_t)r0 * 256, 256, (const bf16_t*)(p.ws + OFF_WM + WM_WKVU) + (size_t)tp * 256 * 256, 256, 256, lds, acc0, acc1);
#define KUP_EPI(ACC, HEAD) do { \
      const int tid = opaque_tid(), lane = tid & 63, w = tid >> 6, wm = w >> 1, l15 = lane & 15; \
      _Pragma("unroll") for (int mt = 0; mt < 4; ++mt) { const float rv = rsqrtf(rsq_kv[r0 + wm * 64 + mt * 16 + l15] * (1.0f / 256.0f) + 1e-6f); \
        _Pragma("unroll") for (int nt = 0; nt < 4; ++nt) ACC[mt][nt] *= rv; } \
      stage_rows<4>(ACC, lds, (bf16_t*)(act + A_KN) + (size_t)r0 * 1024 + (HEAD) * 128, 1024, 1.0f); } while (0)
    KUP_EPI(acc0, 2 * tp);
    KUP_EPI(acc1, 2 * tp + 1);
#undef KUP_EPI
  }
  for (int gid = b_ + ((nq2 + nk2 - b_ + G_ - 1) / G_) * G_; gid < nq2 + 2 * nk2; gid += G_) {
    const int id = gid - nq2 - nk2;
    const int tm = id >> 2, tp = id & 3;
    const int bl = tm / 9, tt = tm - bl * 9;
    const int r0 = tm * 256, t0 = tt * 256;
    f32x4 acc0[4][4], acc1[4][4]; zero_acc(acc0); zero_acc(acc1);
    gemm_tile2<false>((const bf16_t*)(act + A_CKV) + (size_t)r0 * 256, 256, (const bf16_t*)(p.ws + OFF_WM + WM_WKVU) + (size_t)(1024 + tp * 256) * 256, 256, 256, lds, acc0, acc1);
#define VUP_EPI(ACC, HEAD) do { \
      const int tid = opaque_tid(), lane = tid & 63, w = tid >> 6, wm = w >> 1, quad = lane >> 4; \
      _Pragma("unroll") for (int mt = 0; mt < 4; ++mt) { \
        f32x4 rv = *(const f32x4*)(rsq_kv + r0 + wm * 64 + mt * 16 + quad * 4); \
        rv[0] = rsqrtf(rv[0] * (1.0f / 256.0f) + 1e-6f); rv[1] = rsqrtf(rv[1] * (1.0f / 256.0f) + 1e-6f); rv[2] = rsqrtf(rv[2] * (1.0f / 256.0f) + 1e-6f); rv[3] = rsqrtf(rv[3] * (1.0f / 256.0f) + 1e-6f); \
        _Pragma("unroll") for (int nt = 0; nt < 4; ++nt) ACC[mt][nt] *= rv; } \
      stage_cols(ACC, lds, (bf16_t*)(act + A_VT) + ((size_t)bl * 1024 + (HEAD) * 128) * TT + t0); } while (0)
    VUP_EPI(acc0, 2 * tp);
    VUP_EPI(acc1, 2 * tp + 1);
#undef VUP_EPI
  }
}

template <int DKS, int NVT, int MT, bool MLA, bool HP = false>
DI void attn_item(const bf16_t* Qp, int ldq, bf16_t* Op, int ldo, const bf16_t* __restrict__ K1, int ldk1,
                  const bf16_t* __restrict__ K2, const bf16_t* __restrict__ Vt, int qrow0  , int qt0  ,
                  int krow0  , int ta0, int ta1, int tb0, int tb1, bool maskwin, bool has_sink, const float* sinkp,
                  unsigned char* lds) {
  constexpr int DK = DKS * 32, DV = NVT * 16, KSTR = DK * 2, KCH = DK / 8, KBYTES = 64 * KSTR, VBYTES = DV * 144, BUFB = KBYTES + VBYTES;
  const int tid = opaque_tid(), lane = tid & 63, w = tid >> 6, l15 = lane & 15, quad = lane >> 4;
  bf16x8 qf[MT][DKS];
#pragma unroll
  for (int mt = 0; mt < MT; ++mt)
#pragma unroll
    for (int ks = 0; ks < DKS; ++ks)
      qf[mt][ks] = *(const bf16x8*)(Qp + (size_t)(qrow0 + (HP ? w * 16 : w * 16 * MT + mt * 16) + l15) * ldq + (HP ? mt * 64 : 0) + ks * 32 + quad * 8);
  f32x4 o[MT][NVT];
  float mrow[MT], lrow[MT];
#pragma unroll
  for (int mt = 0; mt < MT; ++mt) {
    mrow[mt] = has_sink ? sinkp[HP ? mt : 0] * LOG2E : -INFINITY;
    lrow[mt] = (has_sink && quad == 0) ? 1.0f : 0.0f;
#pragma unroll
    for (int nv = 0; nv < NVT; ++nv) o[mt][nv] = (f32x4){0.f, 0.f, 0.f, 0.f};
  }
  const int na = ta1 - ta0, ntl = na + (tb1 - tb0);
  constexpr int NKL = (64 * KCH) / 512;
  constexpr int NVL = (DV * 8) / 512;
  u32x4 rk[NKL], rv[NVL];
#define AT_LOAD(J) do { const int kt_ = (J) < na ? ta0 + (J) : tb0 + ((J) - na); const size_t kr0_ = (size_t)krow0 + (size_t)kt_ * 64; \
    _Pragma("unroll") for (int i = 0; i < NKL; ++i) { const int idx = tid + 512 * i, key = idx / KCH, cc = idx - key * KCH; \
      if (MLA) rk[i] = (cc < 16) ? *(const u32x4*)(K1 + (kr0_ + key) * ldk1 + cc * 8) : *(const u32x4*)(K2 + (kr0_ + key) * 64 + (cc - 16) * 8); \
      else rk[i] = *(const u32x4*)(K1 + (kr0_ + key) * ldk1 + cc * 8); } \
    _Pragma("unroll") for (int i = 0; i < NVL; ++i) { const int idx = tid + 512 * i, dv = idx >> 3, cc = idx & 7; \
      rv[i] = *(const u32x4*)(Vt + (size_t)dv * TT + kt_ * 64 + cc * 8); } } while (0)
#define AT_STORE(BUF) do { unsigned char* ks_ = lds + (BUF) * BUFB; unsigned char* vs_ = ks_ + KBYTES; \
    _Pragma("unroll") for (int i = 0; i < NKL; ++i) { const int idx = tid + 512 * i, key = idx / KCH, cc = idx - key * KCH; \
      *(u32x4*)(ks_ + key * KSTR + (((cc & ~7) | ((cc & 7) ^ ((key >> 1) & 7))) * 16)) = rk[i]; } \
    _Pragma("unroll") for (int i = 0; i < NVL; ++i) { const int idx = tid + 512 * i, dv = idx >> 3, cc = idx & 7; *(u32x4*)(vs_ + dv * 144 + cc * 16) = rv[i]; } } while (0)
  AT_LOAD(0);
  AT_STORE(0);
  if (ntl > 1) AT_LOAD(1);
  LDS_BARRIER();
  const int ksw = (l15 >> 1) & 7;
  for (int j = 0; j < ntl; ++j) {
    const unsigned char* Ks = lds + (j & 1) * BUFB;
    const unsigned char* Vs = Ks + KBYTES;
    const int kt = j < na ? ta0 + j : tb0 + (j - na);
    const bool masked = maskwin && (j < na);
    f32x4 s[MT][4];
#pragma unroll
    for (int mt = 0; mt < MT; ++mt)
#pragma unroll
      for (int nt = 0; nt < 4; ++nt) s[mt][nt] = (f32x4){0.f, 0.f, 0.f, 0.f};
#pragma unroll
    for (int nt = 0; nt < 4; ++nt)
#pragma unroll
      for (int ks = 0; ks < DKS; ++ks) {
        const int cc = ks * 4 + quad;
        const bf16x8 kf = *(const bf16x8*)(Ks + (nt * 16 + l15) * KSTR + (((cc & ~7) | ((cc & 7) ^ ksw)) * 16));
#pragma unroll
        for (int mt = 0; mt < MT; ++mt) s[mt][nt] = MFMA16(kf, qf[mt][ks], s[mt][nt]);
      }
    bf16x8 pb[MT][2];
#pragma unroll
    for (int mt = 0; mt < MT; ++mt) {
      if (masked) {
        const int tq = qt0 + (HP ? w * 16 : w * 16 * MT + mt * 16) + l15;
#pragma unroll
        for (int nt = 0; nt < 4; ++nt)
#pragma unroll
          for (int i = 0; i < 4; ++i) {
            const int d = kt * 64 + nt * 16 + quad * 4 + i - tq;
            if (d > 128 || d < -128) s[mt][nt][i] = -INFINITY;
          }
      }
      float mx = s[mt][0][0];
#pragma unroll
      for (int nt = 0; nt < 4; ++nt)
#pragma unroll
        for (int i = 0; i < 4; ++i) mx = fmaxf(mx, s[mt][nt][i]);
      mx = fmaxf(mx, shx(mx, lane, 16));
      mx = fmaxf(mx, shx(mx, lane, 32));
      const float mnew = fmaxf(mrow[mt], mx);
      const float alpha = (mnew == -INFINITY) ? 1.0f : __builtin_amdgcn_exp2f(mrow[mt] - mnew);
      const float msub = (mnew == -INFINITY) ? 0.0f : mnew;
      mrow[mt] = mnew;
      float ps = 0.f;
#pragma unroll
      for (int nt = 0; nt < 4; ++nt)
#pragma unroll
        for (int i = 0; i < 4; ++i) { const float pv = __builtin_amdgcn_exp2f(s[mt][nt][i] - msub); s[mt][nt][i] = pv; ps += pv; }
      lrow[mt] = lrow[mt] * alpha + ps;
      if (__any(alpha != 1.0f)) {
#pragma unroll
        for (int nv = 0; nv < NVT; ++nv) o[mt][nv] *= alpha;
      }
#pragma unroll
      for (int k2 = 0; k2 < 2; ++k2) {
        u32x4 pw;
        pw[0] = pk2(s[mt][2 * k2][0], s[mt][2 * k2][1]); pw[1] = pk2(s[mt][2 * k2][2], s[mt][2 * k2][3]);
        pw[2] = pk2(s[mt][2 * k2 + 1][0], s[mt][2 * k2 + 1][1]); pw[3] = pk2(s[mt][2 * k2 + 1][2], s[mt][2 * k2 + 1][3]);
        pb[mt][k2] = __builtin_bit_cast(bf16x8, pw);
      }
    }
#pragma unroll
    for (int nv = 0; nv < NVT; ++nv)
#pragma unroll
      for (int k2 = 0; k2 < 2; ++k2) {
        const s16x4 lo = *(const s16x4*)(Vs + (nv * 16 + l15) * 144 + k2 * 64 + quad * 8);
        const s16x4 hi = *(const s16x4*)(Vs + (nv * 16 + l15) * 144 + k2 * 64 + 32 + quad * 8);
        const bf16x8 vf = __builtin_shufflevector(lo, hi, 0, 1, 2, 3, 4, 5, 6, 7);
#pragma unroll
        for (int mt = 0; mt < MT; ++mt) o[mt][nv] = MFMA16(vf, pb[mt][k2], o[mt][nv]);
      }
    if (j + 1 < ntl) {
      AT_STORE((j + 1) & 1);
      if (j + 2 < ntl) AT_LOAD(j + 2);
    }
    LDS_BARRIER();
  }
#undef AT_LOAD
#undef AT_STORE
#pragma unroll
  for (int mt = 0; mt < MT; ++mt) {
    float lt = lrow[mt];
    lt += shx(lt, lane, 16);
    lt += shx(lt, lane, 32);
    const float inv = 1.0f / lt;
    bf16_t* op = Op + (size_t)(qrow0 + (HP ? w * 16 : w * 16 * MT + mt * 16) + l15) * ldo + (HP ? mt * 64 : 0) + quad * 4;
#pragma unroll
    for (int nv = 0; nv < NVT; ++nv) *(u32x2*)(op + nv * 16) = pk4(o[mt][nv] * inv);
  }
  __syncthreads();
}

DI void gla_chain(const Params& p, int l, int bl, int h, int sl, int dir, unsigned char* lds) {
  unsigned char* act = p.ws + OFF_ACT;
  const bf16_t* GQK = (const bf16_t*)(act + A_GQK);
  const bf16_t* GVT = (const bf16_t*)(act + A_GVT);
  const float* GKR = (const float*)(act + A_GKR);
  bf16_t* OUT = (bf16_t*)(act + (dir ? A_OB : A_H));
  unsigned char* QD = lds + L_QD; unsigned char* KI = lds + L_KI; unsigned char* KET = lds + L_KET; unsigned char* VTs = lds + L_VT; unsigned char* STs = lds + L_ST;
  float* WG = (float*)(lds + L_WG); float* BGs = (float*)(lds + L_BG); float* ETOT = (float*)(lds + L_ETOT);
  const int tid = opaque_tid(), lane = tid & 63, w = tid >> 6, l15 = lane & 15, quad = lane >> 4;
  {
    const float* wg = (dir ? p.w_gk_bwd : p.w_gk_fwd) + (size_t)l * 16 * 512 + h * 128;
    const float* bgp = (dir ? p.b_gk_bwd : p.b_gk_fwd) + (size_t)l * 512 + h * 128;
    for (int i = tid; i < 2048; i += 512) WG[i] = wg[(i >> 7) * 512 + (i & 127)];
    if (tid < 128) BGs[tid] = bgp[tid];
    for (int i = tid; i < 17408 / 4; i += 512) ((unsigned*)STs)[i] = 0u;
  }
  f32x4 S[4];
#pragma unroll
  for (int i = 0; i < 4; ++i) S[i] = (f32x4){0.f, 0.f, 0.f, 0.f};
  u32x4 rq0, rq1, rk0, rk1, rvv; float4 g0, g1, g2, g3;
  const int vv_ = tid >> 3, vch_ = tid & 7;
#define GLA_LOAD(U) do { const int row0_ = bl * TT + (U) * 64; \
    const bf16_t* qp_ = GQK + (size_t)(row0_ + lane) * 1024 + h * 128 + w * 16; \
    rq0 = *(const u32x4*)(qp_); rq1 = *(const u32x4*)(qp_ + 8); rk0 = *(const u32x4*)(qp_ + 512); rk1 = *(const u32x4*)(qp_ + 520); \
    rvv = *(const u32x4*)(GVT + ((size_t)bl * 1024 + h * 256 + sl * 64 + vv_) * TT + (U) * 64 + vch_ * 8); \
    const float* gp_ = GKR + (size_t)(row0_ + lane) * 32 + dir * 16; \
    g0 = *(const float4*)(gp_); g1 = *(const float4*)(gp_ + 4); g2 = *(const float4*)(gp_ + 8); g3 = *(const float4*)(gp_ + 12); } while (0)
  GLA_LOAD(dir ? 35 : 32);
  __syncthreads();
  for (int step = 0; step < 36; ++step) {
    const int u = dir ? (35 - step) : (step < 4 ? 32 + step : step - 4);
    const int row0 = bl * TT + u * 64;
    LDS_BARRIER();
    {
      const float gk[16] = {g0.x, g0.y, g0.z, g0.w, g1.x, g1.y, g1.z, g1.w, g2.x, g2.y, g2.z, g2.w, g3.x, g3.y, g3.z, g3.w};
      f32x2_t z2[8];
#pragma unroll
      for (int j4 = 0; j4 < 4; ++j4) { const float4 bv = *(const float4*)(BGs + w * 16 + j4 * 4); z2[2 * j4] = (f32x2_t){bv.x, bv.y}; z2[2 * j4 + 1] = (f32x2_t){bv.z, bv.w}; }
#pragma unroll
      for (int r = 0; r < 16; ++r) {
        const f32x2_t g2 = (f32x2_t){gk[r], gk[r]};
#pragma unroll
        for (int j4 = 0; j4 < 4; ++j4) {
          const float4 wv = *(const float4*)(WG + r * 128 + w * 16 + j4 * 4);
          z2[2 * j4] = g2 * (f32x2_t){wv.x, wv.y} + z2[2 * j4];
          z2[2 * j4 + 1] = g2 * (f32x2_t){wv.z, wv.w} + z2[2 * j4 + 1];
        }
      }
      float la[16], x[16];
#pragma unroll
      for (int j = 0; j < 16; ++j) {
        const float z = (j & 1) ? z2[j >> 1][1] : z2[j >> 1][0];
        const float t = __builtin_amdgcn_exp2f(-fabsf(z) * LOG2E);
        la[j] = (fminf(z, 0.f) - __builtin_amdgcn_logf(1.0f + t) * 0.6931471805599453f) * (1.0f / 16.0f);
        x[j] = la[j];
      }
#pragma unroll
      for (int j = 0; j < 16; ++j) x[j] += dpp_move<0x111, 0xF, true>(x[j]);
#pragma unroll
      for (int j = 0; j < 16; ++j) x[j] += dpp_move<0x112, 0xF, true>(x[j]);
#pragma unroll
      for (int j = 0; j < 16; ++j) x[j] += dpp_move<0x114, 0xF, true>(x[j]);
#pragma unroll
      for (int j = 0; j < 16; ++j) x[j] += dpp_move<0x118, 0xF, true>(x[j]);
#pragma unroll
      for (int j = 0; j < 16; ++j) x[j] += dpp_move<0x142, 0xA, false>(x[j]);
#pragma unroll
      for (int j = 0; j < 16; ++j) x[j] += dpp_move<0x143, 0xC, false>(x[j]);
      float qd[16], ki[16], et[16];
#pragma unroll
      for (int j = 0; j < 16; ++j) {
        const float tot = __builtin_bit_cast(float, __builtin_amdgcn_readlane(__builtin_bit_cast(int, x[j]), 63));
        const float cum = dir ? (tot - x[j] + la[j]) : x[j];
        const float e = __builtin_amdgcn_exp2f(cum * LOG2E);
        const float ie = __builtin_amdgcn_rcpf(e);
        const float etv = __builtin_amdgcn_exp2f(tot * LOG2E);
        et[j] = etv;
        const unsigned qw = (j < 8) ? rq0[(j & 7) >> 1] : rq1[(j & 7) >> 1];
        const unsigned kw = (j < 8) ? rk0[(j & 7) >> 1] : rk1[(j & 7) >> 1];
        const float qv = (j & 1) ? bfhi(qw) : bflo(qw);
        const float kv = (j & 1) ? bfhi(kw) : bflo(kw);
        qd[j] = qv * e; ki[j] = kv * ie;
        *(bf16_t*)(KET + ((w * 16 + j) * 72 + lane) * 2) = f2bf(kv * etv * ie);
      }
#pragma unroll
      for (int i = 0; i < 2; ++i) {
        u32x4 a, b;
#pragma unroll
        for (int j = 0; j < 4; ++j) { a[j] = pk2(qd[8 * i + 2 * j], qd[8 * i + 2 * j + 1]); b[j] = pk2(ki[8 * i + 2 * j], ki[8 * i + 2 * j + 1]); }
        *(u32x4*)(QD + (lane * 136 + w * 16 + 8 * i) * 2) = a;
        *(u32x4*)(KI + (lane * 136 + w * 16 + 8 * i) * 2) = b;
      }
      if (lane == 0) {
#pragma unroll
        for (int j4 = 0; j4 < 4; ++j4) *(f32x4*)(ETOT + w * 16 + j4 * 4) = (f32x4){et[4 * j4], et[4 * j4 + 1], et[4 * j4 + 2], et[4 * j4 + 3]};
      }
      *(u32x4*)(VTs + (vv_ * 72 + vch_ * 8) * 2) = rvv;
    }
    LDS_BARRIER();
    if (step + 1 < 36) { const int un = dir ? (34 - step) : (step + 1 < 4 ? 33 + step : step - 3); GLA_LOAD(un); }
    {
      const int ct = w & 3, vh = w >> 2;
      bf16x8 qdf[4];
#pragma unroll
      for (int ks = 0; ks < 4; ++ks) qdf[ks] = *(const bf16x8*)(QD + ((ct * 16 + l15) * 136 + ks * 32 + quad * 8) * 2);
      f32x4 sc[4];
#pragma unroll
      for (int nt = 0; nt < 4; ++nt) {
        sc[nt] = (f32x4){0.f, 0.f, 0.f, 0.f};
#pragma unroll
        for (int ks = 0; ks < 4; ++ks) {
          const bf16x8 kf = *(const bf16x8*)(KI + ((nt * 16 + l15) * 136 + ks * 32 + quad * 8) * 2);
          sc[nt] = MFMA16(kf, qdf[ks], sc[nt]);
        }
        const int cidx = ct * 16 + l15;
#pragma unroll
        for (int i = 0; i < 4; ++i) {
          const int sidx = nt * 16 + quad * 4 + i;
          const bool keep = dir ? (sidx > cidx) : (sidx <= cidx);
          if (!keep) sc[nt][i] = 0.f;
        }
      }
      bf16x8 pb[2];
#pragma unroll
      for (int k2 = 0; k2 < 2; ++k2) {
        u32x4 pw;
        pw[0] = pk2(sc[2 * k2][0], sc[2 * k2][1]); pw[1] = pk2(sc[2 * k2][2], sc[2 * k2][3]);
        pw[2] = pk2(sc[2 * k2 + 1][0], sc[2 * k2 + 1][1]); pw[3] = pk2(sc[2 * k2 + 1][2], sc[2 * k2 + 1][3]);
        pb[k2] = __builtin_bit_cast(bf16x8, pw);
      }
#pragma unroll
      for (int nv = 0; nv < 2; ++nv) {
        const int vrow = vh * 32 + nv * 16 + l15;
        f32x4 oo = (f32x4){0.f, 0.f, 0.f, 0.f};
#pragma unroll
        for (int k2 = 0; k2 < 2; ++k2) {
          const s16x4 lo = *(const s16x4*)(VTs + (vrow * 72 + k2 * 32 + quad * 4) * 2);
          const s16x4 hi = *(const s16x4*)(VTs + (vrow * 72 + k2 * 32 + 16 + quad * 4) * 2);
          const bf16x8 vf = __builtin_shufflevector(lo, hi, 0, 1, 2, 3, 4, 5, 6, 7);
          oo = MFMA16(vf, pb[k2], oo);
        }
#pragma unroll
        for (int ks = 0; ks < 4; ++ks) {
          const bf16x8 sf = *(const bf16x8*)(STs + (vrow * 136 + ks * 32 + quad * 8) * 2);
          oo = MFMA16(sf, qdf[ks], oo);
        }
        *(u32x2*)(OUT + (size_t)(row0 + ct * 16 + l15) * 1024 + h * 256 + sl * 64 + vh * 32 + nv * 16 + quad * 4) = pk4(oo);
      }
    }
    LDS_BARRIER();
    {
      const f32x4 dec = *(const f32x4*)(ETOT + w * 16 + quad * 4);
#pragma unroll
      for (int vt = 0; vt < 4; ++vt) S[vt] *= dec;
#pragma unroll
      for (int k2 = 0; k2 < 2; ++k2) {
        const bf16x8 kef = *(const bf16x8*)(KET + ((w * 16 + l15) * 72 + k2 * 32 + quad * 8) * 2);
#pragma unroll
        for (int vt = 0; vt < 4; ++vt) {
          const bf16x8 vf = *(const bf16x8*)(VTs + ((vt * 16 + l15) * 72 + k2 * 32 + quad * 8) * 2);
          S[vt] = MFMA16(kef, vf, S[vt]);
        }
      }
#pragma unroll
      for (int vt = 0; vt < 4; ++vt) *(u32x2*)(STs + ((vt * 16 + l15) * 136 + w * 16 + quad * 4) * 2) = pk4(S[vt]);
    }
  }
#undef GLA_LOAD
  __syncthreads();
}

DI void mixers_phase(const Params& p, int l, int g, bool last, unsigned char* lds) {
  unsigned char* act = p.ws + OFF_ACT;
  const int xcd = blockIdx.x & 7;
  unsigned* ctr = (unsigned*)(p.ws + OFF_CTR) + ((l * NGRP + g) * 8 + xcd);
  int* s_item = (int*)(lds + L_ITEM);
  const int n_gla = BG * 4 * 4 * 2, n_mla = BG * 8 * 8, n_swa = BG * 4 * 16, n_mlac = last ? 0 : BG * 8, n_swac = last ? 0 : BG * 16 * 2;
  const int total = n_gla + n_mla + n_swa + n_mlac + n_swac;
  for (;;) {
    if (opaque_tid() == 0) *s_item = (int)atomicAdd(ctr, 1u);
    __syncthreads();
    int it = *s_item;
    __syncthreads();
    if (it >= total / 8) break;
    if (it < n_gla / 8) {
      it += xcd * (n_gla / 8);
      const int dir = it & 1, sl = (it >> 1) & 3, h = (it >> 3) & 3, bl = it >> 5;
      gla_chain(p, l, bl, h, sl, dir, lds);
      continue;
    }
    it -= n_gla / 8;
    if (it < n_mla / 8) {
      it += xcd * (n_mla / 8);
      const int bl = it >> 6, h = (it >> 3) & 7, qb = it & 7;
      bf16_t* QF = (bf16_t*)(act + A_QF) + h * 192;
      attn_item<6, 8, 2, true>(QF, 1536, QF, 1536, (const bf16_t*)(act + A_KN) + h * 128, 1024, (const bf16_t*)(act + A_KR),
                               (const bf16_t*)(act + A_VT) + ((size_t)bl * 1024 + h * 128) * TT, bl * TT + qb * 256, qb * 256, bl * TT, 0, 36, 0, 0,
                               false, false, nullptr, lds);
      continue;
    }
    it -= n_mla / 8;
    if (it < n_swa / 8) {
      it += xcd * (n_swa / 8);
      const int bl = it >> 6, gk = (it >> 5) & 1, hh = (it >> 4) & 1, qi = it & 15, hq0 = gk * 8 + hh * 4;
      bf16_t* SQ = (bf16_t*)(act + A_SQ) + hq0 * 64;
      const int a0 = (2 * qi - 2) < 0 ? 0 : (2 * qi - 2), a1 = (2 * qi + 4) > 32 ? 32 : (2 * qi + 4);
      attn_item<2, 4, 4, false, true>(SQ, 1024, SQ, 1024, (const bf16_t*)(act + A_SK) + gk * 64, 128, nullptr,
                                      (const bf16_t*)(act + A_SVT) + ((size_t)bl * 128 + gk * 64) * TT, bl * TT + qi * 128, qi * 128, bl * TT, a0, a1, 32, 36,
                                      true, true, p.sinks + l * 16 + hq0, lds);
      continue;
    }
    it -= n_swa / 8;
    if (it < n_mlac / 8) {
      it += xcd * (n_mlac / 8);
      const int bl = it >> 3, h = it & 7;
      bf16_t* QF = (bf16_t*)(act + A_QF) + h * 192;
      attn_item<6, 8, 2, true>(QF, 1536, QF, 1536, (const bf16_t*)(act + A_KN) + h * 128, 1024, (const bf16_t*)(act + A_KR),
                               (const bf16_t*)(act + A_VT) + ((size_t)bl * 1024 + h * 128) * TT, bl * TT + 2048, 2048, bl * TT, 32, 36, 0, 0,
                               false, false, nullptr, lds);
      continue;
    }
    it -= n_mlac / 8;
    {
      it += xcd * (n_swac / 8);
      const int bl = it >> 5, hq = (it >> 1) & 15, half = it & 1, gk = hq >> 3;
      bf16_t* SQ = (bf16_t*)(act + A_SQ) + hq * 64;
      attn_item<2, 4, 1, false>(SQ, 1024, SQ, 1024, (const bf16_t*)(act + A_SK) + gk * 64, 128, nullptr,
                                (const bf16_t*)(act + A_SVT) + ((size_t)bl * 128 + gk * 64) * TT, bl * TT + 2048 + half * 128, 2048 + half * 128, bl * TT,
                                32, 36, 0, 0, false, true, p.sinks + l * 16 + hq, lds);
    }
  }
}

DI void glapost_phase(const Params& p, int l) {
  unsigned char* act = p.ws + OFF_ACT;
  const bf16_t* OF = (const bf16_t*)(act + A_H);
  const bf16_t* OB = (const bf16_t*)(act + A_OB);
  bf16_t* GG = (bf16_t*)(act + A_GG);
  const float* gn = p.gla_norm + l * 256;
  const int tid = opaque_tid(), lane = tid & 63, w = tid >> 6;
  for (int r = blockIdx.x * 8 + w; r < R; r += gridDim.x * 8) {
    const size_t off = (size_t)r * 1024 + lane * 16;
    float v[16];
    float ss = 0.f;
#pragma unroll
    for (int c = 0; c < 2; ++c) {
      const u32x4 a = *(const u32x4*)(OF + off + c * 8), b = *(const u32x4*)(OB + off + c * 8);
#pragma unroll
      for (int j = 0; j < 4; ++j) { v[c * 8 + 2 * j] = bflo(a[j]) + bflo(b[j]); v[c * 8 + 2 * j + 1] = bfhi(a[j]) + bfhi(b[j]); }
    }
#pragma unroll
    for (int j = 0; j < 16; ++j) ss += v[j] * v[j];
#pragma unroll
    for (int o = 8; o >= 1; o >>= 1) ss += shx(ss, lane, o);
    const float rstd = rsqrtf(ss * (1.0f / 256.0f) + 1e-6f);
    const int vcol = (lane & 15) * 16;
#pragma unroll
    for (int c = 0; c < 2; ++c) {
      const u32x4 gq = *(const u32x4*)(GG + off + c * 8);
      u32x4 o;
#pragma unroll
      for (int j = 0; j < 4; ++j) {
        const float g0 = bflo(gq[j]), g1 = bfhi(gq[j]);
        const float y0 = v[c * 8 + 2 * j] * rstd * gn[vcol + c * 8 + 2 * j] * siluf_(g0);
        const float y1 = v[c * 8 + 2 * j + 1] * rstd * gn[vcol + c * 8 + 2 * j + 1] * siluf_(g1);
        o[j] = pk2(y0, y1);
      }
      *(u32x4*)(GG + off + c * 8) = o;
    }
  }
}

#define MERGE_SCALE_T(ACC, NTT, BR, COL0) do { \
      const int tid = opaque_tid(), lane = tid & 63, w = tid >> 6, wm = w >> 1, wn = w & 1, l15 = lane & 15, quad = lane >> 4; \
      const bf16_t* mg = (const bf16_t*)(act + A_MG) + (size_t)r0 * 3072 + (BR) * 1024 + (COL0) + wn * (NTT) * 16; \
      _Pragma("unroll") for (int mt = 0; mt < 4; ++mt) _Pragma("unroll") for (int nt = 0; nt < (NTT); ++nt) { \
          const bf16_t* gp = mg + (size_t)(wm * 64 + mt * 16 + l15) * 3072 + nt * 16 + quad * 4; \
          const u32x2 gw = *(const u32x2*)(gp); \
          f32x4 f = (f32x4){bflo(gw.x), bfhi(gw.x), bflo(gw.y), bfhi(gw.y)}; \
          if ((BR) < 2) { const u32x2 gn = *(const u32x2*)(gp + 1024); \
            f[0] *= __builtin_amdgcn_rcpf(bflo(gn.x)); f[1] *= __builtin_amdgcn_rcpf(bfhi(gn.x)); \
            f[2] *= __builtin_amdgcn_rcpf(bflo(gn.y)); f[3] *= __builtin_amdgcn_rcpf(bfhi(gn.y)); } \
          ACC[mt][nt] *= f; } } while (0)
DI void merge_phase(const Params& p, bool last, unsigned char* lds) {
  unsigned char* act = p.ws + OFF_ACT;
  for (int i_ = 0;; ++i_) {
    int rt, tn;
    if (!unit_order(i_, BG * 8, 8, rt, tn)) break;
    const int tm = (rt / 8) * 9 + (rt & 7);
    const int r0 = tm * 256;
    f32x4 acc[4][4]; zero_acc(acc);
    gemm_tile<true, false>((const bf16_t*)(act + A_GG) + (size_t)r0 * 1024, 1024, (const bf16_t*)(p.ws + OFF_WM + WM_WPA) + (size_t)tn * 128 * 1024, 1024, 1024, lds, acc);
    MERGE_SCALE_T(acc, 4, 0, tn * 128);
    gemm_tile<true, false>((const bf16_t*)(act + A_SQ) + (size_t)r0 * 1024, 1024, (const bf16_t*)(p.ws + OFF_WM + WM_WPB) + (size_t)tn * 128 * 1024, 1024, 1024, lds, acc);
    MERGE_SCALE_T(acc, 4, 1, tn * 128);
    gemm_tile<true, true>((const bf16_t*)(act + A_QF) + (size_t)r0 * 1536, 1536, (const bf16_t*)(p.ws + OFF_WM + WM_WPC) + (size_t)tn * 128 * 1024, 1024, 1024, lds, acc);
    MERGE_SCALE_T(acc, 4, 2, tn * 128);
    stage_rows<4>(acc, lds, (bf16_t*)(act + A_GQK) + (size_t)r0 * 1024 + tn * 128, 1024, 1.0f);
  }
  if (last) return;
  for (int id = blockIdx.x; id < BG * 16; id += gridDim.x) {
    const int tm = (id >> 4) * 9 + 8, t64 = id & 15;
    const int r0 = tm * 256;
    f32x4 acc[4][2];
#pragma unroll
    for (int a_ = 0; a_ < 4; ++a_) { acc[a_][0] = (f32x4){0.f, 0.f, 0.f, 0.f}; acc[a_][1] = (f32x4){0.f, 0.f, 0.f, 0.f}; }
    gemm_tile_n64<false>((const bf16_t*)(act + A_GG) + (size_t)r0 * 1024, 1024, (const bf16_t*)(p.ws + OFF_WM + WM_WPA) + (size_t)t64 * 64 * 1024, 1024, 1024, lds, acc);
    MERGE_SCALE_T(acc, 2, 0, t64 * 64);
    gemm_tile_n64<false>((const bf16_t*)(act + A_SQ) + (size_t)r0 * 1024, 1024, (const bf16_t*)(p.ws + OFF_WM + WM_WPB) + (size_t)t64 * 64 * 1024, 1024, 1024, lds, acc);
    MERGE_SCALE_T(acc, 2, 1, t64 * 64);
    gemm_tile_n64<true>((const bf16_t*)(act + A_QF) + (size_t)r0 * 1536, 1536, (const bf16_t*)(p.ws + OFF_WM + WM_WPC) + (size_t)t64 * 64 * 1024, 1024, 1024, lds, acc);
    MERGE_SCALE_T(acc, 2, 2, t64 * 64);
    stage_rows<2>(acc, lds, (bf16_t*)(act + A_GQK) + (size_t)r0 * 1024 + t64 * 64, 1024, 1.0f);
  }
}
#undef MERGE_SCALE_T

DI void resid_epilogue(const f32x4 (&acc)[4][4], const float* srcp, float* dstp, const float* gate, int wm, int l15, int quad) {
#pragma unroll
  for (int mt = 0; mt < 4; ++mt) {
    const size_t ro = (size_t)(wm * 64 + mt * 16 + l15) * 1024 + quad * 4;
#pragma unroll
    for (int nt = 0; nt < 4; ++nt) {
      const f32x4 xo = *(const f32x4*)(srcp + ro + nt * 16);
      const f32x4 gv = *(const f32x4*)(gate + nt * 16 + quad * 4);
      *(f32x4*)(dstp + ro + nt * 16) = xo + gv * acc[mt][nt];
    }
  }
}

DI void resid_epilogue2(const f32x4 (&acc)[4][2], const float* srcp, float* dstp, const float* gate, int wm, int l15, int quad) {
#pragma unroll
  for (int mt = 0; mt < 4; ++mt) {
    const size_t ro = (size_t)(wm * 64 + mt * 16 + l15) * 1024 + quad * 4;
#pragma unroll
    for (int nt = 0; nt < 2; ++nt) {
      const f32x4 xo = *(const f32x4*)(srcp + ro + nt * 16);
      const f32x4 gv = *(const f32x4*)(gate + nt * 16 + quad * 4);
      *(f32x4*)(dstp + ro + nt * 16) = xo + gv * acc[mt][nt];
    }
  }
}
DI void wo_phase(const Params& p, int l, int g, bool last, unsigned char* lds) {
  unsigned char* act = p.ws + OFF_ACT;
  const float* MOD = (const float*)(p.ws + OFF_MOD);
  float* XC = (float*)(p.ws + OFF_XC);
  for (int i_ = 0;; ++i_) {
    int rt, tn;
    if (!unit_order(i_, BG * 8, 8, rt, tn)) break;
    const int bl = rt >> 3, tt = rt & 7, tm = bl * 9 + tt, b = g * BG + bl;
    const int r0 = tm * 256;
    f32x4 acc[4][4]; zero_acc(acc);
    gemm_tile<true, false>((const bf16_t*)(act + A_GQK) + (size_t)r0 * 1024, 1024, (const bf16_t*)(p.ws + OFF_WM + WM_WO) + (size_t)tn * 128 * 1024, 1024, 1024, lds, acc);
    const int tid = opaque_tid(), lane = tid & 63, w = tid >> 6, wm = w >> 1, wn = w & 1, l15 = lane & 15, quad = lane >> 4;
    const int coff = tn * 128 + wn * 64;
    const size_t base = ((size_t)b * 2048 + tt * 256) * 1024 + coff;
    resid_epilogue(acc, (l == 0 ? p.x : p.out) + base, p.out + base, MOD + (size_t)(l * 9 + b) * 6144 + 2048 + coff, wm, l15, quad);
  }
  if (last) return;
  for (int id = blockIdx.x; id < BG * 16; id += gridDim.x) {
    const int bl = id >> 4, t64 = id & 15, tm = bl * 9 + 8, b = g * BG + bl;
    const int r0 = tm * 256;
    f32x4 acc[4][2];
#pragma unroll
    for (int a_ = 0; a_ < 4; ++a_) { acc[a_][0] = (f32x4){0.f, 0.f, 0.f, 0.f}; acc[a_][1] = (f32x4){0.f, 0.f, 0.f, 0.f}; }
    gemm_tile_n64<false>((const bf16_t*)(act + A_GQK) + (size_t)r0 * 1024, 1024, (const bf16_t*)(p.ws + OFF_WM + WM_WO) + (size_t)t64 * 64 * 1024, 1024, 1024, lds, acc);
    const int tid = opaque_tid(), lane = tid & 63, w = tid >> 6, wm = w >> 1, wn = w & 1, l15 = lane & 15, quad = lane >> 4;
    const int coff = t64 * 64 + wn * 32;
    const size_t base = ((size_t)b * 256) * 1024 + coff;
    resid_epilogue2(acc, (l == 0 ? p.ctx : XC) + base, XC + base, MOD + (size_t)(l * 9 + 8) * 6144 + 2048 + coff, wm, l15, quad);
  }
}

DI void ffnin_epi(const Params& p, const f32x4 (&acc)[4][4], int r0, int tn, unsigned char* lds) {
  unsigned char* act = p.ws + OFF_ACT;
  f32x4 hv[4][2];
#pragma unroll
  for (int mt = 0; mt < 4; ++mt)
#pragma unroll
    for (int np = 0; np < 2; ++np) {
      const f32x4 gte = acc[mt][2 * np], up = acc[mt][2 * np + 1];
#pragma unroll
      for (int i = 0; i < 4; ++i) hv[mt][np][i] = siluf_(gte[i]) * up[i];
    }
  stage_rows<2>(hv, lds, (bf16_t*)(act + F_HID) + (size_t)r0 * 2816 + tn * 64, 2816, 1.0f);
}
DI void ffnin_phase(const Params& p, bool last, unsigned char* lds) {
  unsigned char* act = p.ws + OFF_ACT;
  const int nrt = last ? 64 : 72;
  const int total = nrt * 22, G_ = gridDim.x;
  const int full = (total / G_) * G_;
  for (int i_ = 0; i_ * G_ < full; ++i_) {
    int rt, tp;
    if (!unit_order(i_, nrt, 22, rt, tp)) break;
    const int tm = last ? (rt / 8) * 9 + (rt & 7) : rt;
    const int r0 = tm * 256;
    f32x4 acc0[4][4], acc1[4][4]; zero_acc(acc0); zero_acc(acc1);
    gemm_tile2<true>((const bf16_t*)(act + F_H2) + (size_t)r0 * 1024, 1024, (const bf16_t*)(act + F_WFI) + (size_t)tp * 256 * 1024, 1024, 1024, lds, acc0, acc1);
    ffnin_epi(p, acc0, r0, 2 * tp, lds);
    ffnin_epi(p, acc1, r0, 2 * tp + 1, lds);
  }
  for (int sidx = blockIdx.x; sidx < 2 * (total - full); sidx += G_) {
    int rt, tp;
    if (!unit_of((long)full + (sidx >> 1), nrt, 22, rt, tp)) break;
    const int tm = last ? (rt / 8) * 9 + (rt & 7) : rt;
    const int r0 = tm * 256, tn = 2 * tp + (sidx & 1);
    f32x4 acc[4][4]; zero_acc(acc);
    gemm_tile<true, false>((const bf16_t*)(act + F_H2) + (size_t)r0 * 1024, 1024, (const bf16_t*)(act + F_WFI) + (size_t)tn * 128 * 1024, 1024, 1024, lds, acc);
    ffnin_epi(p, acc, r0, tn, lds);
  }
}

DI void ffnout_epi(const Params& p, const f32x4 (&acc)[4][4], int l, int tm, int tn) {
  const float* MOD = (const float*)(p.ws + OFF_MOD);
  float* XC = (float*)(p.ws + OFF_XC);
  const int tid = opaque_tid(), lane = tid & 63, w = tid >> 6, wm = w >> 1, wn = w & 1, l15 = lane & 15, quad = lane >> 4;
  const int b = tm / 9, tt = tm - b * 9;
  const int coff = tn * 128 + wn * 64;
  if (tt < 8) {
    const size_t base = ((size_t)b * 2048 + tt * 256) * 1024 + coff;
    resid_epilogue(acc, p.out + base, p.out + base, MOD + (size_t)(l * 9 + b) * 6144 + 5120 + coff, wm, l15, quad);
  } else {
    const size_t base = ((size_t)b * 256) * 1024 + coff;
    resid_epilogue(acc, XC + base, XC + base, MOD + (size_t)(l * 9 + 8) * 6144 + 5120 + coff, wm, l15, quad);
  }
}
DI void ffnout_phase(const Params& p, int l, bool last, unsigned char* lds) {
  unsigned char* act = p.ws + OFF_ACT;
  const int nrt = last ? 64 : 72;
  for (int i_ = 0;; ++i_) {
    int rt, tp;
    if (!unit_order(i_, nrt, 4, rt, tp)) break;
    const int tm = last ? (rt / 8) * 9 + (rt & 7) : rt;
    const int r0 = tm * 256;
    f32x4 acc0[4][4], acc1[4][4]; zero_acc(acc0); zero_acc(acc1);
    gemm_tile2<true>((const bf16_t*)(act + F_HID) + (size_t)r0 * 2816, 2816, (const bf16_t*)(act + F_WFO) + (size_t)tp * 256 * 2816, 2816, 2816, lds, acc0, acc1);
    ffnout_epi(p, acc0, l, tm, 2 * tp);
    ffnout_epi(p, acc1, l, tm, 2 * tp + 1);
  }
}

DI void convert_mixer_weights(const Params& p, int l, unsigned char* lds) {
  unsigned char* wm = p.ws + OFF_WM;
  const int tid = opaque_tid(), lane = tid & 63, w = tid >> 6;
  float* wl = (float*)(lds + w * 4352);
  const int total = 13344;
  for (int id = blockIdx.x * 8 + w; id < total; id += gridDim.x * 8) {
    const float* src; int K, N, mode = 0, rem; bf16_t* dst; const float* ks = nullptr;
    if (id < 8160) { src = p.w_in + (size_t)l * 1024 * 8160; K = 1024; N = 8160; dst = (bf16_t*)(wm + WM_WIN); mode = 1; rem = id; }
    else if (id < 8736) { src = p.w_q_up + (size_t)l * 384 * 1536; K = 384; N = 1536; dst = (bf16_t*)(wm + WM_WQU); ks = p.q_norm + l * 384; rem = id - 8160; }
    else if (id < 9248) { src = p.w_kv_up + (size_t)l * 256 * 2048; K = 256; N = 2048; dst = (bf16_t*)(wm + WM_WKVU); ks = p.kv_norm + l * 256; mode = 3; rem = id - 8736; }
    else if (id < 10272) { src = p.w_pa + (size_t)l * 1024 * 1024; K = 1024; N = 1024; dst = (bf16_t*)(wm + WM_WPA); rem = id - 9248; }
    else if (id < 11296) { src = p.w_pb + (size_t)l * 1024 * 1024; K = 1024; N = 1024; dst = (bf16_t*)(wm + WM_WPB); rem = id - 10272; }
    else if (id < 12320) { src = p.w_pc + (size_t)l * 1024 * 1024; K = 1024; N = 1024; dst = (bf16_t*)(wm + WM_WPC); rem = id - 11296; }
    else { src = p.w_o + (size_t)l * 1024 * 1024; K = 1024; N = 1024; dst = (bf16_t*)(wm + WM_WO); rem = id - 12320; }
    convert_wave_tile(src, K, N, dst, mode, ks, rem, wl, lane);
  }
  if (blockIdx.x == 0) { unsigned* z = (unsigned*)(wm + WM_WIN + (size_t)5088 * 1024 * 2); for (int i = tid; i < 32 * 1024 / 2; i += 512) z[i] = 0u; }
  __syncthreads();
}
DI void convert_ffn_weights(const Params& p, int l, unsigned char* lds) {
  unsigned char* act = p.ws + OFF_ACT;
  const int tid = opaque_tid(), lane = tid & 63, w = tid >> 6;
  float* wl = (float*)(lds + w * 4352);
  const int n1 = 16 * 352, total = n1 + 44 * 64;
  for (int id = blockIdx.x * 8 + w; id < total; id += gridDim.x * 8) {
    if (id < n1) convert_wave_tile(p.w_ffn_in + (size_t)l * 1024 * 5632, 1024, 5632, (bf16_t*)(act + F_WFI), 2, nullptr, id, wl, lane);
    else convert_wave_tile(p.w_ffn_out + (size_t)l * 2816 * 1024, 2816, 1024, (bf16_t*)(act + F_WFO), 0, nullptr, id - n1, wl, lane);
  }
  __syncthreads();
}


#define XB_TMO      128
#define XB_XCNT(j)  (256  + 64 * (j))
#define XB_XSUB(j)  (1280 + 64 * (j))
#define XB_XGEN(j)  (2304 + 64 * (j))
#define XB_TOP      3328
#define XB_TOPGEN   3392
#define XCD_BAR_WORDS 3456
#define XB_SPIN_CAP (1u << 18)
DI unsigned xb_ld(unsigned* p)              { return __hip_atomic_load(p, __ATOMIC_RELAXED, __HIP_MEMORY_SCOPE_AGENT); }
DI unsigned xb_add(unsigned* p, unsigned v) { return __hip_atomic_fetch_add(p, v, __ATOMIC_RELAXED, __HIP_MEMORY_SCOPE_AGENT); }
DI unsigned xb_xcc_id() { return (unsigned)__builtin_amdgcn_s_getreg((3 << 11) | 20) & 0xFu; }
#define XB_SPIN(cond, bar) do { unsigned _sp = 0; while (cond) { __builtin_amdgcn_s_sleep(1); \
    if ((++_sp & 255u) == 0u) { if (xb_ld(&(bar)[XB_TMO])) break; if (_sp > XB_SPIN_CAP) { atomicAdd(&(bar)[XB_TMO], 1u); break; } } } } while (0)
struct XcdBarrier { unsigned* bar; unsigned x; volatile LAS unsigned* st; };
DI XcdBarrier xcd_barrier_post(unsigned* bar, volatile LAS unsigned* st) {
  XcdBarrier b; b.bar = bar; b.x = xb_xcc_id(); b.st = st;
  if (threadIdx.x == 0) (void)xb_add(&bar[XB_XCNT(b.x)], 1u);
  return b;
}
DI void xcd_barrier_complete(unsigned* bar, unsigned x, unsigned& nloc, unsigned& nx) {
  const unsigned G = gridDim.x * gridDim.y * gridDim.z;
  unsigned sum, cnt, mine, sp = 0u;
  for (;;) {
    sum = 0u; cnt = 0u; mine = 0u;
#pragma unroll
    for (unsigned j = 0; j < 16; ++j) { const unsigned c = xb_ld(&bar[XB_XCNT(j)]); sum += c; cnt += (c > 0u) ? 1u : 0u; mine = (j == x) ? c : mine; }
    if (sum == G) break;
    __builtin_amdgcn_s_sleep(1);
    if ((++sp & 255u) == 0u) { if (xb_ld(&bar[XB_TMO])) break; if (sp > XB_SPIN_CAP) { atomicAdd(&bar[XB_TMO], 1u); break; } }
  }
  nloc = mine > 0u ? mine : 1u; nx = cnt > 0u ? cnt : 1u;
}
DI void xcd_barrier(const XcdBarrier& b) {
  asm volatile("s_waitcnt vmcnt(0)" ::: "memory");
  __syncthreads();
  if (threadIdx.x == 0) {
    unsigned* bar = b.bar;
    __builtin_amdgcn_s_waitcnt(0);
    unsigned nloc = b.st[0], nx = b.st[1];
    if (nloc == 0u) { xcd_barrier_complete(bar, b.x, nloc, nx); b.st[0] = nloc; b.st[1] = nx; }
    const unsigned old = xb_add(&bar[XB_XSUB(b.x)], 1u);
    const unsigned gen = old / nloc;
    if (old + 1u == (gen + 1u) * nloc) {
      __builtin_amdgcn_fence(__ATOMIC_RELEASE, "agent");
      asm volatile("s_waitcnt vmcnt(0)" ::: "memory");
      const unsigned og = xb_add(&bar[XB_TOP], 1u);
      const unsigned tg = og / nx;
      if (og + 1u == (tg + 1u) * nx) xb_add(&bar[XB_TOPGEN], 1u);
      else XB_SPIN(xb_ld(&bar[XB_TOPGEN]) == tg, bar);
      __builtin_amdgcn_fence(__ATOMIC_ACQUIRE, "agent");
      xb_add(&bar[XB_XGEN(b.x)], 1u);
      asm volatile("s_waitcnt vmcnt(0)" ::: "memory");
    } else {
      XB_SPIN(xb_ld(&bar[XB_XGEN(b.x)]) == gen, bar);
      __builtin_amdgcn_fence(__ATOMIC_ACQUIRE, "agent");
      asm volatile("s_waitcnt vmcnt(0)" ::: "memory");
    }
  }
  __syncthreads();
}

DI void grid_barrier(unsigned* ctr, unsigned& phase) {
  asm volatile("s_waitcnt vmcnt(0)" ::: "memory");
  __syncthreads();
  phase += 1u;
  if (threadIdx.x == 0) {
    __builtin_amdgcn_fence(__ATOMIC_RELEASE, "agent");
    asm volatile("s_waitcnt vmcnt(0)" ::: "memory");
    __hip_atomic_fetch_add(ctr, 1u, __ATOMIC_RELAXED, __HIP_MEMORY_SCOPE_AGENT);
    const unsigned target = phase * gridDim.x;
    unsigned spins = 0;
    while (__hip_atomic_load(ctr, __ATOMIC_RELAXED, __HIP_MEMORY_SCOPE_AGENT) < target) { __builtin_amdgcn_s_sleep(1); if (++spins > (1u << 24)) break; }
    __builtin_amdgcn_fence(__ATOMIC_ACQUIRE, "agent");
    asm volatile("s_waitcnt vmcnt(0)" ::: "memory");
  }
  __syncthreads();
}

__global__ void __launch_bounds__(512) fwd_megakernel(Params p) {
  cg::grid_group grid = cg::this_grid();
  unsigned char* lds = dyn_lds;
  unsigned char* act = p.ws + OFF_ACT;
  unsigned* gbar = (unsigned*)(p.ws + OFF_CTR) + 128;
  unsigned bphase = 0u;
  if (blockIdx.x == 0) { const int t0 = opaque_tid(); if (t0 < 256) ((unsigned*)(p.ws + OFF_CTR))[t0] = 0u;
    for (int i = t0; i < XCD_BAR_WORDS; i += 512) ((unsigned*)(p.ws + OFF_XBAR))[i] = 0u; }
  volatile LAS unsigned* xb_st = (volatile LAS unsigned*)((LAS unsigned char*)dyn_lds + (LDS_BYTES - 32));
  if (threadIdx.x == 0) { xb_st[0] = 0u; xb_st[1] = 0u; }
  grid.sync();
  const XcdBarrier xbar = xcd_barrier_post((unsigned*)(p.ws + OFF_XBAR), xb_st);
  {
    const int tid = opaque_tid(), lane = tid & 63, w = tid >> 6;
    float* sc = (float*)lds;
    float* red = (float*)(lds + 36864);
    float* MOD = (float*)(p.ws + OFF_MOD);
    for (int item = blockIdx.x; item < 192; item += gridDim.x) {
      for (int i = tid; i < 9216; i += 512) { const int b = i >> 10, k = i & 1023; const float v = b < 8 ? p.c[b * 1024 + k] : p.c_ctx[k]; sc[i] = siluf_(v); }
      __syncthreads();
      const int l = item / 96, cb = (item % 96) * 64;
      float a[9];
#pragma unroll
      for (int b = 0; b < 9; ++b) a[b] = 0.f;
      const float* wp = p.w_mod + ((size_t)l * 1024 + w * 128) * 6144 + cb + lane;
#pragma unroll 8
      for (int k = 0; k < 128; ++k) {
        const float wv = wp[(size_t)k * 6144];
#pragma unroll
        for (int b = 0; b < 9; ++b) a[b] += sc[b * 1024 + w * 128 + k] * wv;
      }
#pragma unroll
      for (int b = 0; b < 9; ++b) red[(w * 9 + b) * 64 + lane] = a[b];
      __syncthreads();
      for (int i = tid; i < 576; i += 512) {
        const int b = i >> 6, ln = i & 63;
        float s = 0.f;
        for (int ww = 0; ww < 8; ++ww) s += red[(ww * 9 + b) * 64 + ln];
        MOD[(size_t)(l * 9 + b) * 6144 + cb + ln] = s + p.b_mod[l * 6144 + cb + ln];
      }
      __syncthreads();
    }
    if (blockIdx.x == gridDim.x - 1) {
      float2* rope = (float2*)(p.ws + OFF_ROPE);
      for (int i = tid; i < 1024; i += 512) {
        const int pos = i >> 4, f = i & 15;
        const float inv = powf(10000.0f, -(float)f / 16.0f);
        const float ang = (float)pos * inv;
        rope[i] = make_float2(cosf(ang), sinf(ang));
      }
    }
  }
  for (int l_ = 0; l_ < 2; ++l_) {
    int l = l_; asm volatile("" : "+s"(l));
    const bool last = (l == 1);
    convert_mixer_weights(p, l, lds);
    xcd_barrier(xbar);
    for (int g = 0; g < NGRP; ++g) {
      if (g == 0) {
        { float* rsq = (float*)(p.ws + OFF_RSQ); for (int i = blockIdx.x * 512 + opaque_tid(); i < 2 * R; i += gridDim.x * 512) rsq[i] = 0.f; }
        norm_phase(p, l, 0, 0, BG, l == 0 ? p.x : p.out, l == 0 ? p.ctx : (const float*)(p.ws + OFF_XC), (bf16_t*)(act + A_H), false);
        xcd_barrier(xbar);
      }
      inproj_phase(p, g, lds);
      xcd_barrier(xbar);
      mlaup_phase(p, last, lds);
      xcd_barrier(xbar);
      mixers_phase(p, l, g, last, lds);
      xcd_barrier(xbar);
      glapost_phase(p, l);
      xcd_barrier(xbar);
      merge_phase(p, last, lds);
      xcd_barrier(xbar);
      wo_phase(p, l, g, last, lds);
      if (g == NGRP - 1) { __syncthreads(); convert_ffn_weights(p, l, lds); }
      if (g == 0) {
        { float* rsq = (float*)(p.ws + OFF_RSQ); for (int i = blockIdx.x * 512 + opaque_tid(); i < 2 * R; i += gridDim.x * 512) rsq[i] = 0.f; }
        norm_phase(p, l, 0, BG, BG, l == 0 ? p.x : p.out, l == 0 ? p.ctx : (const float*)(p.ws + OFF_XC), (bf16_t*)(act + A_H), false);
      }
      xcd_barrier(xbar);
    }
    {
      norm_phase(p, l, 1, 0, 8, p.out, (const float*)(p.ws + OFF_XC), (bf16_t*)(act + F_H2), last);
    }
    xcd_barrier(xbar);
    ffnin_phase(p, last, lds);
    xcd_barrier(xbar);
    ffnout_phase(p, l, last, lds);
    xcd_barrier(xbar);
  }
  const int tid = opaque_tid(), lane = tid & 63, w = tid >> 6;
  for (int r = blockIdx.x * 8 + w; r < 16384; r += gridDim.x * 8) {
    float* xp = p.out + (size_t)r * 1024;
    float4 v[4]; float ss = 0.f;
#pragma unroll
    for (int i = 0; i < 4; ++i) { v[i] = *(const float4*)(xp + lane * 4 + 256 * i); ss += v[i].x * v[i].x + v[i].y * v[i].y + v[i].z * v[i].z + v[i].w * v[i].w; }
#pragma unroll
    for (int o = 32; o >= 1; o >>= 1) ss += shx(ss, lane, o);
    const float rstd = rsqrtf(ss * (1.0f / 1024.0f) + 1e-6f);
#pragma unroll
    for (int i = 0; i < 4; ++i) {
      const float4 gn = *(const float4*)(p.final_norm + lane * 4 + 256 * i);
      float4 o; o.x = v[i].x * rstd * gn.x; o.y = v[i].y * rstd * gn.y; o.z = v[i].z * rstd * gn.z; o.w = v[i].w * rstd * gn.w;
      *(float4*)(xp + lane * 4 + 256 * i) = o;
    }
  }
}

extern "C" void kernel_launch(void* const* d_in, const int* in_sizes, int n_in, void* d_out, int out_size, void* d_ws, size_t ws_size,
                              hipStream_t stream) {
  constexpr size_t kDynLds = LDS_BYTES;
  static int grid_blocks = 0;
  if (!grid_blocks) {
    int dev = 0, cus = 0, per_cu = 0;
    hipGetDevice(&dev);
    hipDeviceGetAttribute(&cus, hipDeviceAttributeMultiprocessorCount, dev);
    hipFuncSetAttribute((const void*)fwd_megakernel, hipFuncAttributeMaxDynamicSharedMemorySize, (int)kDynLds);
    hipOccupancyMaxActiveBlocksPerMultiprocessor(&per_cu, fwd_megakernel, 512, kDynLds);
    if (per_cu < 1) per_cu = 1;
    if (per_cu > 1) per_cu = 1;
    grid_blocks = cus * per_cu;
  }
  if (ws_size < WS_NEED) { fprintf(stderr, "workspace too small: %zu < %zu\n", ws_size, (size_t)WS_NEED); }
  Params p{};
  const float** pp = (const float**)&p;
  for (int i = 0; i < 26; ++i) pp[i] = (const float*)d_in[i];
  p.out = (float*)d_out;
  p.ws = (unsigned char*)d_ws;
  void* args[] = {&p};
  hipError_t e = hipLaunchCooperativeKernel((void*)fwd_megakernel, dim3(grid_blocks), dim3(512), args, kDynLds, stream);
  if (e != hipSuccess) fprintf(stderr, "cooperative launch failed: %s (grid %d)\n", hipGetErrorString(e), grid_blocks);
}
```

```cpp
#include <hip/hip_runtime.h>
#include <hip/hip_cooperative_groups.h>
#include <cstdio>
#include <cstdint>
namespace cg = cooperative_groups;
#define DI __device__ __forceinline__
typedef unsigned short bf16_t;
typedef short bf16x8 __attribute__((ext_vector_type(8)));
typedef short s16x4 __attribute__((ext_vector_type(4)));
typedef float f32x4 __attribute__((ext_vector_type(4)));
typedef unsigned u32x2 __attribute__((ext_vector_type(2)));
typedef unsigned u32x4 __attribute__((ext_vector_type(4)));

constexpr int TT = 2304;
constexpr int BG = 4;
constexpr int NGRP = 2;
constexpr int R = BG * TT;
constexpr int RALL = 8 * TT;
constexpr float LOG2E = 1.4426950408889634f;

constexpr size_t OFF_CTR = 0;
constexpr size_t OFF_MOD = 4096;
constexpr size_t OFF_ROPE = OFF_MOD + 2 * 9 * 6144 * 4;
constexpr size_t OFF_RSQ = OFF_ROPE + 64 * 16 * 8;
constexpr size_t OFF_XBAR = OFF_RSQ + (size_t)2 * R * 4;
constexpr size_t OFF_XC = OFF_XBAR + 16384;
constexpr size_t OFF_WM = OFF_XC + (size_t)2048 * 1024 * 4;
constexpr size_t WM_WIN = 0;
constexpr size_t WM_WQU = WM_WIN + (size_t)8192 * 1024 * 2;
constexpr size_t WM_WKVU = WM_WQU + (size_t)1536 * 384 * 2;
constexpr size_t WM_WPA = WM_WKVU + (size_t)2048 * 256 * 2;
constexpr size_t WM_WPB = WM_WPA + (size_t)1024 * 1024 * 2;
constexpr size_t WM_WPC = WM_WPB + (size_t)1024 * 1024 * 2;
constexpr size_t WM_WO = WM_WPC + (size_t)1024 * 1024 * 2;
constexpr size_t WM_SIZE = WM_WO + (size_t)1024 * 1024 * 2;
constexpr size_t OFF_ACT = OFF_WM + WM_SIZE;
constexpr size_t A_H = 0;
constexpr size_t A_GQK = A_H + (size_t)R * 2048;
constexpr size_t A_GVT = A_GQK + (size_t)R * 2048;
constexpr size_t A_GG = A_GVT + (size_t)R * 2048;
constexpr size_t A_GKR = A_GG + (size_t)R * 2048;
constexpr size_t A_SQ = A_GKR + (size_t)R * 128;
constexpr size_t A_SK = A_SQ + (size_t)R * 2048;
constexpr size_t A_SVT = A_SK + (size_t)R * 256;
constexpr size_t A_CQ = A_SVT + (size_t)R * 256;
constexpr size_t A_CKV = A_CQ + (size_t)R * 768;
constexpr size_t A_KR = A_CKV + (size_t)R * 512;
constexpr size_t A_QF = A_KR + (size_t)R * 128;
constexpr size_t A_KN = A_QF + (size_t)R * 3072;
constexpr size_t A_VT = A_KN + (size_t)R * 2048;
constexpr size_t A_MG = A_VT + (size_t)R * 2048;
constexpr size_t A_OB = A_MG + (size_t)R * 6144;
constexpr size_t ACT_SIZE = A_OB + (size_t)R * 2048;
constexpr size_t F_H2 = 0;
constexpr size_t F_HID = F_H2 + (size_t)RALL * 2048;
constexpr size_t F_WFI = F_HID + (size_t)RALL * 5632;
constexpr size_t F_WFO = F_WFI + (size_t)5632 * 1024 * 2;
constexpr size_t WS_NEED = OFF_ACT + ACT_SIZE;

constexpr int LDS_BYTES = 151552;
constexpr int G_BUF = 49152, G_BOFF = 32768, G_EXTRA = 147456;
constexpr int L_QD = 0, L_KI = L_QD + 17408, L_KET = L_KI + 17408, L_VT = L_KET + 18432, L_ST = L_VT + 9216,
              L_WG = L_ST + 17408, L_BG = L_WG + 8192, L_ETOT = L_BG + 512, L_END = L_ETOT + 512;
constexpr int L_ITEM = LDS_BYTES - 16;
static_assert(L_END <= L_ITEM, "lds");

struct Params {
  const float *x, *c, *ctx, *c_ctx, *w_mod, *b_mod, *norm_mix, *w_in, *w_gk_fwd, *b_gk_fwd, *w_gk_bwd, *b_gk_bwd, *gla_norm, *sinks,
      *q_norm, *w_q_up, *kv_norm, *w_kv_up, *w_pa, *w_pb, *w_pc, *w_o, *norm_ffn, *w_ffn_in, *w_ffn_out, *final_norm;
  float* out;
  unsigned char* ws;
};

extern __shared__ __attribute__((aligned(16))) unsigned char dyn_lds[];

typedef __bf16 bf16x2_t __attribute__((ext_vector_type(2)));
typedef float f32x2_t __attribute__((ext_vector_type(2)));
DI unsigned pk2(float lo, float hi) { f32x2_t f = {lo, hi}; bf16x2_t v = __builtin_convertvector(f, bf16x2_t); return __builtin_bit_cast(unsigned, v); }
DI float bflo(unsigned w) { return __uint_as_float(w << 16); }
DI float bfhi(unsigned w) { return __uint_as_float(w & 0xffff0000u); }
DI float bf2f(bf16_t v) { return __uint_as_float(((unsigned)v) << 16); }
DI bf16_t f2bf(float x) { return (bf16_t)(pk2(x, 0.f) & 0xffffu); }
DI u32x2 pk4(f32x4 v) { u32x2 r; r.x = pk2(v[0], v[1]); r.y = pk2(v[2], v[3]); return r; }
DI float sigmoidf_(float x) { return __builtin_amdgcn_rcpf(1.0f + __builtin_amdgcn_exp2f(-1.4426950408889634f * x)); }
DI float siluf_(float x) { return x * __builtin_amdgcn_rcpf(1.0f + __builtin_amdgcn_exp2f(-1.4426950408889634f * x)); }
DI int opaque_tid() { int t = threadIdx.x; asm volatile("" : "+v"(t)); return t; }

template <int CTRL, int ROWMASK, bool BOUND>
DI float dpp_move(float x) { return __builtin_bit_cast(float, __builtin_amdgcn_update_dpp(0, __builtin_bit_cast(int, x), CTRL, ROWMASK, 0xF, BOUND)); }
DI float wave_incl_scan(float x) {
  x += dpp_move<0x111, 0xF, true>(x);
  x += dpp_move<0x112, 0xF, true>(x);
  x += dpp_move<0x114, 0xF, true>(x);
  x += dpp_move<0x118, 0xF, true>(x);
  x += dpp_move<0x142, 0xA, false>(x);
  x += dpp_move<0x143, 0xC, false>(x);
  return x;
}
DI float shx(float v, int lane, int m) { return __builtin_bit_cast(float, __builtin_amdgcn_ds_bpermute((lane ^ m) << 2, __builtin_bit_cast(int, v))); }
#define LDS_BARRIER() do { asm volatile("s_waitcnt lgkmcnt(0)" ::: "memory"); __builtin_amdgcn_s_barrier(); asm volatile("" ::: "memory"); } while (0)
#define MFMA16(a, b, c) __builtin_amdgcn_mfma_f32_16x16x32_bf16((a), (b), (c), 0, 0, 0)

#define LAS __attribute__((address_space(3)))
template <bool SWAP, bool ASEG, bool DEEP = true>
DI void gemm_tile(const bf16_t* __restrict__ A, int lda, const bf16_t* __restrict__ Bt, int ldb, int K, unsigned char* lds,
                  f32x4 (&acc)[4][4]) {
  const int tid = opaque_tid(), lane = tid & 63, w = tid >> 6, wm = w >> 1, wn = w & 1, l15 = lane & 15, quad = lane >> 4;
  const int lrow = tid >> 3;
  const int lchs = (tid & 7) ^ ((lrow >> 1) & 7);
  const int nk = K >> 6;
  const unsigned voffA = (unsigned)(lrow * lda + lchs * 8) * 2u, voffB = (unsigned)(lrow * ldb + lchs * 8) * 2u;
  const char* Ab = (const char*)A; const char* Bb = (const char*)Bt;
  LAS unsigned char* l3 = (LAS unsigned char*)dyn_lds;
  const int sw0 = ((quad ^ (l15 >> 1)) * 16), sw1 = (((4 + quad) ^ (l15 >> 1)) * 16);
  const int arow = (wm * 64 + l15) * 128, brow = G_BOFF + (wn * 64 + l15) * 128;
#define GT_DMA(KT, ST) do { const int ku_ = ASEG ? (((KT) >> 1) * 192 + ((KT) & 1) * 64) : (KT) * 64; \
    _Pragma("unroll") for (int i = 0; i < 4; ++i) __builtin_amdgcn_global_load_lds((const unsigned*)(Ab + (size_t)(64 * i * lda + ku_) * 2 + voffA), \
        (LAS unsigned*)(l3 + (ST) * G_BUF + i * 8192 + w * 1024), 16, 0, 0); \
    _Pragma("unroll") for (int i = 0; i < 2; ++i) __builtin_amdgcn_global_load_lds((const unsigned*)(Bb + (size_t)(64 * i * ldb + (KT) * 64) * 2 + voffB), \
        (LAS unsigned*)(l3 + (ST) * G_BUF + G_BOFF + i * 8192 + w * 1024), 16, 0, 0); } while (0)
#define GT_READ(AF, BF, ST, KS) do { const unsigned char* base_ = lds + (ST) * G_BUF + ((KS) ? sw1 : sw0); \
    _Pragma("unroll") for (int mt = 0; mt < 4; ++mt) AF[mt] = *(const bf16x8*)(base_ + arow + mt * 16 * 128); \
    _Pragma("unroll") for (int nt = 0; nt < 4; ++nt) BF[nt] = *(const bf16x8*)(base_ + brow + nt * 16 * 128); } while (0)
#define GT_MMA(AF, BF) do { _Pragma("unroll") for (int mt = 0; mt < 4; ++mt) _Pragma("unroll") for (int nt = 0; nt < 4; ++nt) \
      acc[mt][nt] = SWAP ? MFMA16(BF[nt], AF[mt], acc[mt][nt]) : MFMA16(AF[mt], BF[nt], acc[mt][nt]); } while (0)
  bf16x8 fa0[4], fb0[4], fa1[4], fb1[4];
  GT_DMA(0, 0);
  GT_DMA(1, 1);
  asm volatile("s_waitcnt vmcnt(6)" ::: "memory");
  LDS_BARRIER();
  int st = 0;
  for (int kt = 0; kt < nk; ++kt) {
    const bool more2 = (kt + 2 < nk);
    if (more2) { const int s2 = st == 0 ? 2 : st - 1; GT_DMA(kt + 2, s2); }
    GT_READ(fa0, fb0, st, 0);
    GT_READ(fa1, fb1, st, 1);
    GT_MMA(fa0, fb0);
    GT_MMA(fa1, fb1);
    if (more2) asm volatile("s_waitcnt vmcnt(6)" ::: "memory"); else asm volatile("s_waitcnt vmcnt(0)" ::: "memory");
    LDS_BARRIER();
    st = st == 2 ? 0 : st + 1;
  }
#undef GT_DMA
#undef GT_READ
#undef GT_MMA
}
template <bool ASEG>
DI void gemm_tile_n64(const bf16_t* __restrict__ A, int lda, const bf16_t* __restrict__ Bt, int ldb, int K, unsigned char* lds,
                      f32x4 (&acc)[4][2]) {
  const int tid = opaque_tid(), lane = tid & 63, w = tid >> 6, wm = w >> 1, wn = w & 1, l15 = lane & 15, quad = lane >> 4;
  const int lrow = tid >> 3;
  const int lchs = (tid & 7) ^ ((lrow >> 1) & 7);
  const int nk = K >> 6;
  const unsigned voffA = (unsigned)(lrow * lda + lchs * 8) * 2u, voffB = (unsigned)(lrow * ldb + lchs * 8) * 2u;
  const char* Ab = (const char*)A; const char* Bb = (const char*)Bt;
  LAS unsigned char* l3 = (LAS unsigned char*)dyn_lds;
  const int sw0 = ((quad ^ (l15 >> 1)) * 16), sw1 = (((4 + quad) ^ (l15 >> 1)) * 16);
  const int arow = (wm * 64 + l15) * 128, brow = G_BOFF + (wn * 32 + l15) * 128;
#define GN_DMA(KT, ST) do { const int ku_ = ASEG ? (((KT) >> 1) * 192 + ((KT) & 1) * 64) : (KT) * 64; \
    _Pragma("unroll") for (int i = 0; i < 4; ++i) __builtin_amdgcn_global_load_lds((const unsigned*)(Ab + (size_t)(64 * i * lda + ku_) * 2 + voffA), \
        (LAS unsigned*)(l3 + (ST) * G_BUF + i * 8192 + w * 1024), 16, 0, 0); \
    __builtin_amdgcn_global_load_lds((const unsigned*)(Bb + (size_t)((KT) * 64) * 2 + voffB), (LAS unsigned*)(l3 + (ST) * G_BUF + G_BOFF + w * 1024), 16, 0, 0); } while (0)
  GN_DMA(0, 0);
  GN_DMA(1, 1);
  asm volatile("s_waitcnt vmcnt(5)" ::: "memory");
  LDS_BARRIER();
  int st = 0;
  for (int kt = 0; kt < nk; ++kt) {
    const bool more2 = (kt + 2 < nk);
    if (more2) { const int s2 = st == 0 ? 2 : st - 1; GN_DMA(kt + 2, s2); }
#pragma unroll
    for (int ks = 0; ks < 2; ++ks) {
      const unsigned char* base_ = lds + st * G_BUF + (ks ? sw1 : sw0);
      bf16x8 fa[4], fb[2];
#pragma unroll
      for (int mt = 0; mt < 4; ++mt) fa[mt] = *(const bf16x8*)(base_ + arow + mt * 16 * 128);
#pragma unroll
      for (int nt = 0; nt < 2; ++nt) fb[nt] = *(const bf16x8*)(base_ + brow + nt * 16 * 128);
#pragma unroll
      for (int mt = 0; mt < 4; ++mt)
#pragma unroll
        for (int nt = 0; nt < 2; ++nt) acc[mt][nt] = MFMA16(fb[nt], fa[mt], acc[mt][nt]);
    }
    if (more2) asm volatile("s_waitcnt vmcnt(5)" ::: "memory"); else asm volatile("s_waitcnt vmcnt(0)" ::: "memory");
    LDS_BARRIER();
    st = st == 2 ? 0 : st + 1;
  }
#undef GN_DMA
}
DI void zero_acc(f32x4 (&acc)[4][4]) {
#pragma unroll
  for (int a = 0; a < 4; ++a)
#pragma unroll
    for (int b = 0; b < 4; ++b) acc[a][b] = (f32x4){0.f, 0.f, 0.f, 0.f};
}

template <bool SWAP>
DI void gemm_tile2(const bf16_t* __restrict__ A, int lda, const bf16_t* __restrict__ Bt, int ldb, int K, unsigned char* lds,
                   f32x4 (&acc0)[4][4], f32x4 (&acc1)[4][4]) {
  const int tid = opaque_tid(), lane = tid & 63, w = tid >> 6, wm = w >> 1, wn = w & 1, l15 = lane & 15, quad = lane >> 4;
  const int lrow = tid >> 3;
  const int lchs = (tid & 7) ^ ((lrow >> 1) & 7);
  const int nk = K >> 6;
  const unsigned voffA = (unsigned)(lrow * lda + lchs * 8) * 2u, voffB = (unsigned)(lrow * ldb + lchs * 8) * 2u;
  const char* Ab = (const char*)A; const char* Bb = (const char*)Bt;
  LAS unsigned char* l3 = (LAS unsigned char*)dyn_lds;
  const int sw0 = ((quad ^ (l15 >> 1)) * 16), sw1 = (((4 + quad) ^ (l15 >> 1)) * 16);
  const int arow = (wm * 64 + l15) * 128, brow = 32768 + (wn * 64 + l15) * 128;
  constexpr int SB = 65536;
#define G2_DMA(KT, ST) do { \
    _Pragma("unroll") for (int i = 0; i < 4; ++i) __builtin_amdgcn_global_load_lds((const unsigned*)(Ab + (size_t)(64 * i * lda + (KT) * 64) * 2 + voffA), \
        (LAS unsigned*)(l3 + (ST) * SB + i * 8192 + w * 1024), 16, 0, 0); \
    _Pragma("unroll") for (int i = 0; i < 4; ++i) __builtin_amdgcn_global_load_lds((const unsigned*)(Bb + (size_t)(64 * i * ldb + (KT) * 64) * 2 + voffB), \
        (LAS unsigned*)(l3 + (ST) * SB + 32768 + i * 8192 + w * 1024), 16, 0, 0); } while (0)
  G2_DMA(0, 0);
  asm volatile("s_waitcnt vmcnt(0)" ::: "memory");
  LDS_BARRIER();
  for (int kt = 0; kt < nk; ++kt) {
    const int st = kt & 1;
    if (kt + 1 < nk) G2_DMA(kt + 1, st ^ 1);
#pragma unroll
    for (int ks = 0; ks < 2; ++ks) {
      const unsigned char* base_ = lds + st * SB + (ks ? sw1 : sw0);
      bf16x8 fa[4], fb0[4], fb1[4];
#pragma unroll
      for (int mt = 0; mt < 4; ++mt) fa[mt] = *(const bf16x8*)(base_ + arow + mt * 16 * 128);
#pragma unroll
      for (int nt = 0; nt < 4; ++nt) fb0[nt] = *(const bf16x8*)(base_ + brow + nt * 16 * 128);
#pragma unroll
      for (int nt = 0; nt < 4; ++nt) fb1[nt] = *(const bf16x8*)(base_ + brow + 128 * 128 + nt * 16 * 128);
#pragma unroll
      for (int mt = 0; mt < 4; ++mt)
#pragma unroll
        for (int nt = 0; nt < 4; ++nt) acc0[mt][nt] = SWAP ? MFMA16(fb0[nt], fa[mt], acc0[mt][nt]) : MFMA16(fa[mt], fb0[nt], acc0[mt][nt]);
#pragma unroll
      for (int mt = 0; mt < 4; ++mt)
#pragma unroll
        for (int nt = 0; nt < 4; ++nt) acc1[mt][nt] = SWAP ? MFMA16(fb1[nt], fa[mt], acc1[mt][nt]) : MFMA16(fa[mt], fb1[nt], acc1[mt][nt]);
    }
    asm volatile("s_waitcnt vmcnt(0)" ::: "memory");
    LDS_BARRIER();
  }
#undef G2_DMA
}


DI bool unit_of(long L, int nM, int nN, int& pm, int& pn);
DI bool unit_order(int i, int nM, int nN, int& pm, int& pn) { return unit_of((long)i * gridDim.x + blockIdx.x, nM, nN, pm, pn); }
DI bool unit_of(long L, int nM, int nN, int& pm, int& pn) {
  const int nwg = nM * nN;
  if (L >= nwg) return false;
  int wgid = (int)L;
  { const int q = nwg / 8, r = nwg % 8, xcd = wgid % 8, off = wgid / 8; wgid = (xcd < r ? xcd * (q + 1) : r * (q + 1) + (xcd - r) * q) + off; }
  const int nig = 8 * nN, gid = wgid / nig, fm = gid * 8, gsz = (nM - fm) < 8 ? (nM - fm) : 8;
  pm = fm + ((wgid % nig) % gsz); pn = (wgid % nig) / gsz;
  return true;
}

DI int colmap(int mode, int n) {
  if (mode == 1) { if (n < 3072) return n; if (n < 3104) return n + 1984; if (n < 5088) return n - 32; return n + 32; }
  if (mode == 3) { return ((n >> 7) & 1) * 1024 + (n >> 8) * 128 + (n & 127); }
  if (mode == 2) { if (n < 2816) return (n >> 4) * 32 + (n & 15); const int j = n - 2816; return (j >> 4) * 32 + 16 + (j & 15); }
  return n;
}
DI void convert_wave_tile(const float* __restrict__ src, int K, int N, bf16_t* __restrict__ dst, int mode, const float* __restrict__ kscale,
                          int tile, float* wl, int lane) {
  const int ntn = N >> 4;
  const int tk = tile / ntn, tn = tile - tk * ntn;
  const int k0 = tk * 64, n0 = tn * 16;
  const float* sp = src + (size_t)(k0 + lane) * N + n0;
  const float4 v0 = *(const float4*)(sp), v1 = *(const float4*)(sp + 4), v2 = *(const float4*)(sp + 8), v3 = *(const float4*)(sp + 12);
  const float sc = kscale ? kscale[k0 + lane] : 1.0f;
  float* wr = wl + lane * 17;
  wr[0] = v0.x * sc; wr[1] = v0.y * sc; wr[2] = v0.z * sc; wr[3] = v0.w * sc; wr[4] = v1.x * sc; wr[5] = v1.y * sc; wr[6] = v1.z * sc; wr[7] = v1.w * sc;
  wr[8] = v2.x * sc; wr[9] = v2.y * sc; wr[10] = v2.z * sc; wr[11] = v2.w * sc; wr[12] = v3.x * sc; wr[13] = v3.y * sc; wr[14] = v3.z * sc; wr[15] = v3.w * sc;
  __builtin_amdgcn_fence(__ATOMIC_RELEASE, "wavefront");
  __builtin_amdgcn_wave_barrier();
  __builtin_amdgcn_fence(__ATOMIC_ACQUIRE, "wavefront");
  const int n = lane >> 2, kq = (lane & 3) * 16;
  const int np = colmap(mode, n0 + n);
  u32x4 o0, o1;
#pragma unroll
  for (int j = 0; j < 4; ++j) { o0[j] = pk2(wl[(kq + 2 * j) * 17 + n], wl[(kq + 2 * j + 1) * 17 + n]); o1[j] = pk2(wl[(kq + 8 + 2 * j) * 17 + n], wl[(kq + 9 + 2 * j) * 17 + n]); }
  bf16_t* dp = dst + (size_t)np * K + k0 + kq;
  *(u32x4*)(dp) = o0; *(u32x4*)(dp + 8) = o1;
  __builtin_amdgcn_fence(__ATOMIC_RELEASE, "wavefront");
  __builtin_amdgcn_wave_barrier();
  __builtin_amdgcn_fence(__ATOMIC_ACQUIRE, "wavefront");
}

DI void norm_phase(const Params& p, int l, int which, int b0, int nb, const float* xsrc, const float* csrc, bf16_t* H, bool skipctx) {
  const int tid = opaque_tid(), lane = tid & 63, w = tid >> 6;
  const float* MOD = (const float*)(p.ws + OFF_MOD);
  const float* gain = (which ? p.norm_ffn : p.norm_mix) + l * 1024;
  const int rows = nb * TT;
  for (int r = blockIdx.x * 8 + w; r < rows; r += gridDim.x * 8) {
    const int bl = r / TT, t = r - bl * TT, b = b0 + bl;
    if (t >= 2048 && skipctx) continue;
    const float* src = (t < 2048) ? xsrc + ((size_t)b * 2048 + t) * 1024 : csrc + ((size_t)b * 256 + (t - 2048)) * 1024;
    const float* mrow = MOD + (size_t)(l * 9 + (t < 2048 ? b : 8)) * 6144 + which * 3072;
    float4 v[4]; float ss = 0.f;
#pragma unroll
    for (int i = 0; i < 4; ++i) { v[i] = *(const float4*)(src + lane * 4 + 256 * i); ss += v[i].x * v[i].x + v[i].y * v[i].y + v[i].z * v[i].z + v[i].w * v[i].w; }
#pragma unroll
    for (int o = 32; o >= 1; o >>= 1) ss += shx(ss, lane, o);
    const float rstd = rsqrtf(ss * (1.0f / 1024.0f) + 1e-6f);
#pragma unroll
    for (int i = 0; i < 4; ++i) {
      const int col = lane * 4 + 256 * i;
      const float4 g = *(const float4*)(gain + col), sh = *(const float4*)(mrow + col), sc = *(const float4*)(mrow + 1024 + col);
      f32x4 o;
      o[0] = v[i].x * rstd * g.x * (1.f + sc.x) + sh.x; o[1] = v[i].y * rstd * g.y * (1.f + sc.y) + sh.y;
      o[2] = v[i].z * rstd * g.z * (1.f + sc.z) + sh.z; o[3] = v[i].w * rstd * g.w * (1.f + sc.w) + sh.w;
      *(u32x2*)(H + (size_t)r * 1024 + col) = pk4(o);
    }
  }
}

DI void rope_acc(f32x4 (&acc)[4][4], const float2* __restrict__ rope, int t0  , int l15, int quad) {
#pragma unroll
  for (int mt = 0; mt < 4; ++mt) {
    const int t = t0 + mt * 16 + l15;
    const int prow = t >> 6, pcol = t & 63;
    const float4* rpr = (const float4*)(rope + prow * 16 + quad * 4);
    const float4* rpc = (const float4*)(rope + pcol * 16 + quad * 4);
    const float4 r01 = rpr[0], r23 = rpr[1], c01 = rpc[0], c23 = rpc[1];
#pragma unroll
    for (int i = 0; i < 4; ++i) {
      const float2 cr = i == 0 ? make_float2(r01.x, r01.y) : i == 1 ? make_float2(r01.z, r01.w) : i == 2 ? make_float2(r23.x, r23.y) : make_float2(r23.z, r23.w);
      const float2 cc = i == 0 ? make_float2(c01.x, c01.y) : i == 1 ? make_float2(c01.z, c01.w) : i == 2 ? make_float2(c23.x, c23.y) : make_float2(c23.z, c23.w);
      const float a1 = acc[mt][0][i], a2 = acc[mt][1][i];
      acc[mt][0][i] = a1 * cr.x - a2 * cr.y; acc[mt][1][i] = a2 * cr.x + a1 * cr.y;
      const float b1 = acc[mt][2][i], b2 = acc[mt][3][i];
      acc[mt][2][i] = b1 * cc.x - b2 * cc.y; acc[mt][3][i] = b2 * cc.x + b1 * cc.y;
    }
    asm volatile("" ::: "memory");
  }
}
DI void store_rows_direct(const f32x4 (&acc)[4][4], bf16_t* dst, int ld, int wm, int l15, int quad, float scale) {
#pragma unroll
  for (int mt = 0; mt < 4; ++mt) {
    bf16_t* rp = dst + (size_t)(wm * 64 + mt * 16 + l15) * ld + quad * 4;
#pragma unroll
    for (int nt = 0; nt < 4; ++nt) *(u32x2*)(rp + nt * 16) = pk4(acc[mt][nt] * scale);
  }
}
template <int NT>
DI void stage_rows(const f32x4 (&v)[4][NT], unsigned char* lds, bf16_t* dst, int ld, float scale) {
  const int tid = opaque_tid(), lane = tid & 63, w = tid >> 6, wm = w >> 1, wn = w & 1, l15 = lane & 15, quad = lane >> 4;
  constexpr int NC = NT * 32, RS = (NC + 8) * 2, CH = NC / 8, PER = (256 * CH) / 512;
#pragma unroll
  for (int mt = 0; mt < 4; ++mt)
#pragma unroll
    for (int nt = 0; nt < NT; ++nt)
      *(u32x2*)(lds + (wm * 64 + mt * 16 + l15) * RS + (wn * NT * 16 + nt * 16 + quad * 4) * 2) = pk4(v[mt][nt] * scale);
  LDS_BARRIER();
#pragma unroll
  for (int i = 0; i < PER; ++i) {
    const int id = tid + 512 * i, row = id / CH, ch = id % CH;
    const u32x4 x = *(const u32x4*)(lds + row * RS + ch * 16);
    *(u32x4*)(dst + (size_t)row * ld + ch * 8) = x;
  }
  LDS_BARRIER();
}
DI void stage_cols(const f32x4 (&v)[4][4], unsigned char* lds, bf16_t* dst) {
  const int tid = opaque_tid(), lane = tid & 63, w = tid >> 6, wm = w >> 1, wn = w & 1, l15 = lane & 15, quad = lane >> 4;
#pragma unroll
  for (int mt = 0; mt < 4; ++mt)
#pragma unroll
    for (int nt = 0; nt < 4; ++nt)
      *(u32x2*)(lds + (wn * 64 + nt * 16 + l15) * 528 + (wm * 64 + mt * 16 + quad * 4) * 2) = pk4(v[mt][nt]);
  LDS_BARRIER();
#pragma unroll
  for (int i = 0; i < 8; ++i) {
    const int id = tid + 512 * i, row = id >> 5, ch = id & 31;
    const u32x4 x = *(const u32x4*)(lds + row * 528 + ch * 16);
    *(u32x4*)(dst + (size_t)row * TT + ch * 8) = x;
  }
  LDS_BARRIER();
}

DI void inproj_epi(const Params& p, f32x4 (&acc)[4][4], int tm, int tn, unsigned char* lds) {
  unsigned char* act = p.ws + OFF_ACT;
  const float2* rope = (const float2*)(p.ws + OFF_ROPE);
  const int bl = tm / 9, tt = tm - bl * 9;
  const bool latent = tt < 8;
  const int r0 = tm * 256, t0 = tt * 256;
  {
    const int tid = opaque_tid(), lane = tid & 63, w = tid >> 6, wm = w >> 1, wn = w & 1, l15 = lane & 15, quad = lane >> 4;
    const int wt0 = t0 + wm * 64;
    if (tn < 4) {
      stage_rows<4>(acc, lds, (bf16_t*)(act + A_GQK) + (size_t)r0 * 1024 + tn * 128, 1024, 0.08838834764831845f);
    } else if (tn < 8) {
      stage_rows<4>(acc, lds, (bf16_t*)(act + A_GQK) + (size_t)r0 * 1024 + 512 + (tn - 4) * 128, 1024, 1.0f);
    } else if (tn < 16) {
      stage_cols(acc, lds, (bf16_t*)(act + A_GVT) + ((size_t)bl * 1024 + (tn - 8) * 128) * TT + t0);
    } else if (tn < 24) {
      stage_rows<4>(acc, lds, (bf16_t*)(act + A_GG) + (size_t)r0 * 1024 + (tn - 16) * 128, 1024, 1.0f);
    } else if (tn < 32) {
      if (latent) rope_acc(acc, rope, wt0, l15, quad);
      stage_rows<4>(acc, lds, (bf16_t*)(act + A_SQ) + (size_t)r0 * 1024 + (tn - 24) * 128, 1024, 0.125f * LOG2E);
    } else if (tn == 32) {
      if (latent) rope_acc(acc, rope, wt0, l15, quad);
      stage_rows<4>(acc, lds, (bf16_t*)(act + A_SK) + (size_t)r0 * 128, 128, 1.0f);
    } else if (tn == 33) {
      stage_cols(acc, lds, (bf16_t*)(act + A_SVT) + ((size_t)bl * 128) * TT + t0);
    } else if (tn < 39) {
      float* rsq = (float*)(p.ws + OFF_RSQ) + (tn < 37 ? 0 : R) + r0;
#pragma unroll
      for (int mt = 0; mt < 4; ++mt) {
        float ss = 0.f;
#pragma unroll
        for (int nt = 0; nt < 4; ++nt) { const f32x4 v = acc[mt][nt]; ss += v[0] * v[0] + v[1] * v[1] + v[2] * v[2] + v[3] * v[3]; }
        ss += shx(ss, lane, 16); ss += shx(ss, lane, 32);
        if (quad == 0) atomicAdd(rsq + wm * 64 + mt * 16 + l15, ss);
      }
      if (tn < 37) stage_rows<4>(acc, lds, (bf16_t*)(act + A_CQ) + (size_t)r0 * 384 + (tn - 34) * 128, 384, 1.0f);
      else stage_rows<4>(acc, lds, (bf16_t*)(act + A_CKV) + (size_t)r0 * 256 + (tn - 37) * 128, 256, 1.0f);
    } else if (tn == 39) {
      if (wn == 0) {
        if (latent) rope_acc(acc, rope, wt0, l15, quad);
        store_rows_direct(acc, (bf16_t*)(act + A_KR) + (size_t)r0 * 64, 64, wm, l15, quad, 1.0f);
      } else {
        float* gkr = (float*)(act + A_GKR);
#pragma unroll
        for (int mt = 0; mt < 4; ++mt)
#pragma unroll
          for (int nt = 0; nt < 2; ++nt)
            *(f32x4*)(gkr + (size_t)(r0 + wm * 64 + mt * 16 + l15) * 32 + nt * 16 + quad * 4) = acc[mt][nt];
      }
    } else {
#pragma unroll
      for (int mt = 0; mt < 4; ++mt)
#pragma unroll
        for (int nt = 0; nt < 4; ++nt) {
          f32x4 v = acc[mt][nt];
          v[0] = fmaxf(sigmoidf_(v[0]), 1e-6f); v[1] = fmaxf(sigmoidf_(v[1]), 1e-6f); v[2] = fmaxf(sigmoidf_(v[2]), 1e-6f); v[3] = fmaxf(sigmoidf_(v[3]), 1e-6f);
          acc[mt][nt] = v;
        }
      stage_rows<4>(acc, lds, (bf16_t*)(act + A_MG) + (size_t)r0 * 3072 + (tn - 40) * 128, 3072, 1.0f);
    }
  }
}
DI void inproj_phase(const Params& p, int g, unsigned char* lds) {
  unsigned char* act = p.ws + OFF_ACT;
  const bf16_t* H = (const bf16_t*)(act + A_H);
  const bf16_t* W = (const bf16_t*)(p.ws + OFF_WM + WM_WIN);
  const int nunits = (R / 256) * 33;
  (void)nunits;
  for (int i_ = 0;; ++i_) {
    int tm, u;
    if (!unit_order(i_, R / 256, 33, tm, u)) break;
    const int r0 = tm * 256;
    if (u < 31) {
      const int tn0 = 2 * (u < 16 ? u : u + 1);
      f32x4 acc0[4][4], acc1[4][4]; zero_acc(acc0); zero_acc(acc1);
      if (tn0 >= 8 && tn0 < 16) gemm_tile2<false>(H + (size_t)r0 * 1024, 1024, W + (size_t)tn0 * 128 * 1024, 1024, 1024, lds, acc0, acc1);
      else gemm_tile2<true>(H + (size_t)r0 * 1024, 1024, W + (size_t)tn0 * 128 * 1024, 1024, 1024, lds, acc0, acc1);
      inproj_epi(p, acc0, tm, tn0, lds);
      inproj_epi(p, acc1, tm, tn0 + 1, lds);
    } else {
      const int tn = u + 1;
      f32x4 acc[4][4]; zero_acc(acc);
      if (tn == 33) gemm_tile<false, false>(H + (size_t)r0 * 1024, 1024, W + (size_t)tn * 128 * 1024, 1024, 1024, lds, acc);
      else gemm_tile<true, false>(H + (size_t)r0 * 1024, 1024, W + (size_t)tn * 128 * 1024, 1024, 1024, lds, acc);
      inproj_epi(p, acc, tm, tn, lds);
    }
  }
}

template <int K>
DI void row_rstd(const bf16_t* __restrict__ A, float* rs, int tid) {
  const int row = tid >> 1, half = tid & 1;
  const bf16_t* ap = A + (size_t)row * K + half * (K / 2);
  float ss = 0.f;
#pragma unroll 4
  for (int c = 0; c < K / 16; ++c) {
    const u32x4 v = *(const u32x4*)(ap + c * 8);
#pragma unroll
    for (int j = 0; j < 4; ++j) { const float a = bflo(v[j]), b = bfhi(v[j]); ss += a * a + b * b; }
  }
  ss += shx(ss, tid & 63, 1);
  if (half == 0) rs[row] = rsqrtf(ss / (float)K + 1e-6f);
}
DI void mlaup_phase(const Params& p, bool last, unsigned char* lds) {
  unsigned char* act = p.ws + OFF_ACT;
  const float2* rope = (const float2*)(p.ws + OFF_ROPE);
  const float* rsq_q = (const float*)(p.ws + OFF_RSQ);
  const float* rsq_kv = rsq_q + R;
  const int nrt_q = last ? BG * 8 : BG * 9;
  const int nq2 = nrt_q * 6, nk2 = (R / 256) * 4;
  const int G_ = gridDim.x, b_ = blockIdx.x;
  for (int id = b_; id < nq2; id += G_) {
    const int rt = id / 6, tp = id - rt * 6;
    const int tm = last ? (rt / 8) * 9 + (rt & 7) : rt;
    const int bl = tm / 9, tt = tm - bl * 9;
    const bool latent = tt < 8;
    const int r0 = tm * 256, t0 = tt * 256;
    f32x4 acc0[4][4], acc1[4][4]; zero_acc(acc0); zero_acc(acc1);
    gemm_tile2<true>((const bf16_t*)(act + A_CQ) + (size_t)r0 * 384, 384, (const bf16_t*)(p.ws + OFF_WM + WM_WQU) + (size_t)tp * 256 * 384, 384, 384, lds, acc0, acc1);
#define QUP_EPI(ACC, TN) do { \
      const int tid = opaque_tid(), lane = tid & 63, w = tid >> 6, wm = w >> 1, wn = w & 1, l15 = lane & 15, quad = lane >> 4; \
      const float sc = 0.07216878364870322f * LOG2E; \
      _Pragma("unroll") for (int mt = 0; mt < 4; ++mt) { const float rv = rsqrtf(rsq_q[r0 + wm * 64 + mt * 16 + l15] * (1.0f / 384.0f) + 1e-6f) * sc; \
        _Pragma("unroll") for (int nt = 0; nt < 4; ++nt) ACC[mt][nt] *= rv; } \
      const int g64 = (TN) * 2 + wn; \
      if ((g64 % 3) == 2 && latent) rope_acc(ACC, rope, t0 + wm * 64, l15, quad); \
      stage_rows<4>(ACC, lds, (bf16_t*)(act + A_QF) + (size_t)r0 * 1536 + (TN) * 128, 1536, 1.0f); } while (0)
    QUP_EPI(acc0, 2 * tp);
    QUP_EPI(acc1, 2 * tp + 1);
#undef QUP_EPI
  }
  for (int gid = b_ + ((nq2 - b_ + G_ - 1) / G_) * G_; gid < nq2 + nk2; gid += G_) {
    const int id = gid - nq2;
    const int tm = id >> 2, tp = id & 3;
    const int r0 = tm * 256;
    f32x4 acc0[4][4], acc1[4][4]; zero_acc(acc0); zero_acc(acc1);
    gemm_tile2<true>((const bf16_t*)(act + A_CKV) + (size_t)r0 * 256, 256, (const bf16_t*)(p.ws + OFF_WM + WM_WKVU) + (size_t)tp * 256 * 256, 256, 256, lds, acc0, acc1);
#define KUP_EPI(ACC, HEAD) do { \
      const int tid = opaque_tid(), lane = tid & 63, w = tid >> 6, wm = w >> 1, l15 = lane & 15; \
      _Pragma("unroll") for (int mt = 0; mt < 4; ++mt) { const float rv = rsqrtf(rsq_kv[r0 + wm * 64 + mt * 16 + l15] * (1.0f / 256.0f) + 1e-6f); \
        _Pragma("unroll") for (int nt = 0; nt < 4; ++nt) ACC[mt][nt] *= rv; } \
      stage_rows<4>(ACC, lds, (bf16_t*)(act + A_KN) + (size_t)r0 * 1024 + (HEAD) * 128, 1024, 1.0f); } while (0)
    KUP_EPI(acc0, 2 * tp);
    KUP_EPI(acc1, 2 * tp + 1);
#undef KUP_EPI
  }
  for (int gid = b_ + ((nq2 + nk2 - b_ + G_ - 1) / G_) * G_; gid < nq2 + 2 * nk2; gid += G_) {
    const int id = gid - nq2 - nk2;
    const int tm = id >> 2, tp = id & 3;
    const int bl = tm / 9, tt = tm - bl * 9;
    const int r0 = tm * 256, t0 = tt * 256;
    f32x4 acc0[4][4], acc1[4][4]; zero_acc(acc0); zero_acc(acc1);
    gemm_tile2<false>((const bf16_t*)(act + A_CKV) + (size_t)r0 * 256, 256, (const bf16_t*)(p.ws + OFF_WM + WM_WKVU) + (size_t)(1024 + tp * 256) * 256, 256, 256, lds, acc0, acc1);
#define VUP_EPI(ACC, HEAD) do { \
      const int tid = opaque_tid(), lane = tid & 63, w = tid >> 6, wm = w >> 1, quad = lane >> 4; \
      _Pragma("unroll") for (int mt = 0; mt < 4; ++mt) { \
        f32x4 rv = *(const f32x4*)(rsq_kv + r0 + wm * 64 + mt * 16 + quad * 4); \
        rv[0] = rsqrtf(rv[0] * (1.0f / 256.0f) + 1e-6f); rv[1] = rsqrtf(rv[1] * (1.0f / 256.0f) + 1e-6f); rv[2] = rsqrtf(rv[2] * (1.0f / 256.0f) + 1e-6f); rv[3] = rsqrtf(rv[3] * (1.0f / 256.0f) + 1e-6f); \
        _Pragma("unroll") for (int nt = 0; nt < 4; ++nt) ACC[mt][nt] *= rv; } \
      stage_cols(ACC, lds, (bf16_t*)(act + A_VT) + ((size_t)bl * 1024 + (HEAD) * 128) * TT + t0); } while (0)
    VUP_EPI(acc0, 2 * tp);
    VUP_EPI(acc1, 2 * tp + 1);
#undef VUP_EPI
  }
}

template <int DKS, int NVT, int MT, bool MLA, bool HP = false>
DI void attn_item(const bf16_t* Qp, int ldq, bf16_t* Op, int ldo, const bf16_t* __restrict__ K1, int ldk1,
                  const bf16_t* __restrict__ K2, const bf16_t* __restrict__ Vt, int qrow0  , int qt0  ,
                  int krow0  , int ta0, int ta1, int tb0, int tb1, bool maskwin, bool has_sink, const float* sinkp,
                  unsigned char* lds) {
  constexpr int DK = DKS * 32, DV = NVT * 16, KSTR = DK * 2, KCH = DK / 8, KBYTES = 64 * KSTR, VBYTES = DV * 144, BUFB = KBYTES + VBYTES;
  const int tid = opaque_tid(), lane = tid & 63, w = tid >> 6, l15 = lane & 15, quad = lane >> 4;
  bf16x8 qf[MT][DKS];
#pragma unroll
  for (int mt = 0; mt < MT; ++mt)
#pragma unroll
    for (int ks = 0; ks < DKS; ++ks)
      qf[mt][ks] = *(const bf16x8*)(Qp + (size_t)(qrow0 + (HP ? w * 16 : w * 16 * MT + mt * 16) + l15) * ldq + (HP ? mt * 64 : 0) + ks * 32 + quad * 8);
  f32x4 o[MT][NVT];
  float mrow[MT], lrow[MT];
#pragma unroll
  for (int mt = 0; mt < MT; ++mt) {
    mrow[mt] = has_sink ? sinkp[HP ? mt : 0] * LOG2E : -INFINITY;
    lrow[mt] = (has_sink && quad == 0) ? 1.0f : 0.0f;
#pragma unroll
    for (int nv = 0; nv < NVT; ++nv) o[mt][nv] = (f32x4){0.f, 0.f, 0.f, 0.f};
  }
  const int na = ta1 - ta0, ntl = na + (tb1 - tb0);
  constexpr int NKL = (64 * KCH) / 512;
  constexpr int NVL = (DV * 8) / 512;
  u32x4 rk[NKL], rv[NVL];
#define AT_LOAD(J) do { const int kt_ = (J) < na ? ta0 + (J) : tb0 + ((J) - na); const size_t kr0_ = (size_t)krow0 + (size_t)kt_ * 64; \
    _Pragma("unroll") for (int i = 0; i < NKL; ++i) { const int idx = tid + 512 * i, key = idx / KCH, cc = idx - key * KCH; \
      if (MLA) rk[i] = (cc < 16) ? *(const u32x4*)(K1 + (kr0_ + key) * ldk1 + cc * 8) : *(const u32x4*)(K2 + (kr0_ + key) * 64 + (cc - 16) * 8); \
      else rk[i] = *(const u32x4*)(K1 + (kr0_ + key) * ldk1 + cc * 8); } \
    _Pragma("unroll") for (int i = 0; i < NVL; ++i) { const int idx = tid + 512 * i, dv = idx >> 3, cc = idx & 7; \
      rv[i] = *(const u32x4*)(Vt + (size_t)dv * TT + kt_ * 64 + cc * 8); } } while (0)
#define AT_STORE(BUF) do { unsigned char* ks_ = lds + (BUF) * BUFB; unsigned char* vs_ = ks_ + KBYTES; \
    _Pragma("unroll") for (int i = 0; i < NKL; ++i) { const int idx = tid + 512 * i, key = idx / KCH, cc = idx - key * KCH; \
      *(u32x4*)(ks_ + key * KSTR + (((cc & ~7) | ((cc & 7) ^ ((key >> 1) & 7))) * 16)) = rk[i]; } \
    _Pragma("unroll") for (int i = 0; i < NVL; ++i) { const int idx = tid + 512 * i, dv = idx >> 3, cc = idx & 7; *(u32x4*)(vs_ + dv * 144 + cc * 16) = rv[i]; } } while (0)
  AT_LOAD(0);
  AT_STORE(0);
  if (ntl > 1) AT_LOAD(1);
  LDS_BARRIER();
  const int ksw = (l15 >> 1) & 7;
  for (int j = 0; j < ntl; ++j) {
    const unsigned char* Ks = lds + (j & 1) * BUFB;
    const unsigned char* Vs = Ks + KBYTES;
    const int kt = j < na ? ta0 + j : tb0 + (j - na);
    const bool masked = maskwin && (j < na);
    f32x4 s[MT][4];
#pragma unroll
    for (int mt = 0; mt < MT; ++mt)
#pragma unroll
      for (int nt = 0; nt < 4; ++nt) s[mt][nt] = (f32x4){0.f, 0.f, 0.f, 0.f};
#pragma unroll
    for (int nt = 0; nt < 4; ++nt)
#pragma unroll
      for (int ks = 0; ks < DKS; ++ks) {
        const int cc = ks * 4 + quad;
        const bf16x8 kf = *(const bf16x8*)(Ks + (nt * 16 + l15) * KSTR + (((cc & ~7) | ((cc & 7) ^ ksw)) * 16));
#pragma unroll
        for (int mt = 0; mt < MT; ++mt) s[mt][nt] = MFMA16(kf, qf[mt][ks], s[mt][nt]);
      }
    bf16x8 pb[MT][2];
#pragma unroll
    for (int mt = 0; mt < MT; ++mt) {
      if (masked) {
        const int tq = qt0 + (HP ? w * 16 : w * 16 * MT + mt * 16) + l15;
#pragma unroll
        for (int nt = 0; nt < 4; ++nt)
#pragma unroll
          for (int i = 0; i < 4; ++i) {
            const int d = kt * 64 + nt * 16 + quad * 4 + i - tq;
            if (d > 128 || d < -128) s[mt][nt][i] = -INFINITY;
          }
      }
      float mx = s[mt][0][0];
#pragma unroll
      for (int nt = 0; nt < 4; ++nt)
#pragma unroll
        for (int i = 0; i < 4; ++i) mx = fmaxf(mx, s[mt][nt][i]);
      mx = fmaxf(mx, shx(mx, lane, 16));
      mx = fmaxf(mx, shx(mx, lane, 32));
      const float mnew = fmaxf(mrow[mt], mx);
      const float alpha = (mnew == -INFINITY) ? 1.0f : __builtin_amdgcn_exp2f(mrow[mt] - mnew);
      const float msub = (mnew == -INFINITY) ? 0.0f : mnew;
      mrow[mt] = mnew;
      float ps = 0.f;
#pragma unroll
      for (int nt = 0; nt < 4; ++nt)
#pragma unroll
        for (int i = 0; i < 4; ++i) { const float pv = __builtin_amdgcn_exp2f(s[mt][nt][i] - msub); s[mt][nt][i] = pv; ps += pv; }
      lrow[mt] = lrow[mt] * alpha + ps;
      if (__any(alpha != 1.0f)) {
#pragma unroll
        for (int nv = 0; nv < NVT; ++nv) o[mt][nv] *= alpha;
      }
#pragma unroll
      for (int k2 = 0; k2 < 2; ++k2) {
        u32x4 pw;
        pw[0] = pk2(s[mt][2 * k2][0], s[mt][2 * k2][1]); pw[1] = pk2(s[mt][2 * k2][2], s[mt][2 * k2][3]);
        pw[2] = pk2(s[mt][2 * k2 + 1][0], s[mt][2 * k2 + 1][1]); pw[3] = pk2(s[mt][2 * k2 + 1][2], s[mt][2 * k2 + 1][3]);
        pb[mt][k2] = __builtin_bit_cast(bf16x8, pw);
      }
    }
#pragma unroll
    for (int nv = 0; nv < NVT; ++nv)
#pragma unroll
      for (int k2 = 0; k2 < 2; ++k2) {
        const s16x4 lo = *(const s16x4*)(Vs + (nv * 16 + l15) * 144 + k2 * 64 + quad * 8);
        const s16x4 hi = *(const s16x4*)(Vs + (nv * 16 + l15) * 144 + k2 * 64 + 32 + quad * 8);
        const bf16x8 vf = __builtin_shufflevector(lo, hi, 0, 1, 2, 3, 4, 5, 6, 7);
#pragma unroll
        for (int mt = 0; mt < MT; ++mt) o[mt][nv] = MFMA16(vf, pb[mt][k2], o[mt][nv]);
      }
    if (j + 1 < ntl) {
      AT_STORE((j + 1) & 1);
      if (j + 2 < ntl) AT_LOAD(j + 2);
    }
    LDS_BARRIER();
  }
#undef AT_LOAD
#undef AT_STORE
  {
    constexpr int OC = HP ? MT * 64 : DV, ORS = (OC + 8) * 2, OROWS = HP ? 128 : 128 * MT, OCH = OC / 8, OPER = (OROWS * OCH) / 512;
#pragma unroll
    for (int mt = 0; mt < MT; ++mt) {
      float lt = lrow[mt];
      lt += shx(lt, lane, 16);
      lt += shx(lt, lane, 32);
      const float inv = 1.0f / lt;
      const int rowl = (HP ? w * 16 : w * 16 * MT + mt * 16) + l15;
      unsigned char* orow = lds + rowl * ORS + ((HP ? mt * 64 : 0) + quad * 4) * 2;
#pragma unroll
      for (int nv = 0; nv < NVT; ++nv) *(u32x2*)(orow + nv * 32) = pk4(o[mt][nv] * inv);
    }
    LDS_BARRIER();
#pragma unroll
    for (int i = 0; i < OPER; ++i) {
      const int id = tid + 512 * i, row = id / OCH, ch = id - row * OCH;
      const u32x4 x = *(const u32x4*)(lds + row * ORS + ch * 16);
      *(u32x4*)(Op + (size_t)(qrow0 + row) * ldo + ch * 8) = x;
    }
  }
  __syncthreads();
}

DI void gla_chain(const Params& p, int l, int bl, int h, int sl, int dir, unsigned char* lds) {
  unsigned char* act = p.ws + OFF_ACT;
  const bf16_t* GQK = (const bf16_t*)(act + A_GQK);
  const bf16_t* GVT = (const bf16_t*)(act + A_GVT);
  const float* GKR = (const float*)(act + A_GKR);
  bf16_t* OUT = (bf16_t*)(act + (dir ? A_OB : A_H));
  unsigned char* QD = lds + L_QD; unsigned char* KI = lds + L_KI; unsigned char* KET = lds + L_KET; unsigned char* VTs = lds + L_VT; unsigned char* STs = lds + L_ST;
  float* WG = (float*)(lds + L_WG); float* BGs = (float*)(lds + L_BG); float* ETOT = (float*)(lds + L_ETOT);
  const int tid = opaque_tid(), lane = tid & 63, w = tid >> 6, l15 = lane & 15, quad = lane >> 4;
  {
    const float* wg = (dir ? p.w_gk_bwd : p.w_gk_fwd) + (size_t)l * 16 * 512 + h * 128;
    const float* bgp = (dir ? p.b_gk_bwd : p.b_gk_fwd) + (size_t)l * 512 + h * 128;
    for (int i = tid; i < 2048; i += 512) WG[i] = wg[(i >> 7) * 512 + (i & 127)];
    if (tid < 128) BGs[tid] = bgp[tid];
    for (int i = tid; i < 17408 / 4; i += 512) ((unsigned*)STs)[i] = 0u;
  }
  f32x4 S[4];
#pragma unroll
  for (int i = 0; i < 4; ++i) S[i] = (f32x4){0.f, 0.f, 0.f, 0.f};
  u32x4 rq0, rq1, rk0, rk1, rvv; float4 g0, g1, g2, g3;
  const int vv_ = tid >> 3, vch_ = tid & 7;
#define GLA_LOAD(U) do { const int row0_ = bl * TT + (U) * 64; \
    const bf16_t* qp_ = GQK + (size_t)(row0_ + lane) * 1024 + h * 128 + w * 16; \
    rq0 = *(const u32x4*)(qp_); rq1 = *(const u32x4*)(qp_ + 8); rk0 = *(const u32x4*)(qp_ + 512); rk1 = *(const u32x4*)(qp_ + 520); \
    rvv = *(const u32x4*)(GVT + ((size_t)bl * 1024 + h * 256 + sl * 64 + vv_) * TT + (U) * 64 + vch_ * 8); \
    const float* gp_ = GKR + (size_t)(row0_ + lane) * 32 + dir * 16; \
    g0 = *(const float4*)(gp_); g1 = *(const float4*)(gp_ + 4); g2 = *(const float4*)(gp_ + 8); g3 = *(const float4*)(gp_ + 12); } while (0)
  GLA_LOAD(dir ? 35 : 32);
  __syncthreads();
  for (int step = 0; step < 36; ++step) {
    const int u = dir ? (35 - step) : (step < 4 ? 32 + step : step - 4);
    const int row0 = bl * TT + u * 64;
    LDS_BARRIER();
    {
      const float gk[16] = {g0.x, g0.y, g0.z, g0.w, g1.x, g1.y, g1.z, g1.w, g2.x, g2.y, g2.z, g2.w, g3.x, g3.y, g3.z, g3.w};
      f32x2_t z2[8];
#pragma unroll
      for (int j4 = 0; j4 < 4; ++j4) { const float4 bv = *(const float4*)(BGs + w * 16 + j4 * 4); z2[2 * j4] = (f32x2_t){bv.x, bv.y}; z2[2 * j4 + 1] = (f32x2_t){bv.z, bv.w}; }
#pragma unroll
      for (int r = 0; r < 16; ++r) {
        const f32x2_t g2 = (f32x2_t){gk[r], gk[r]};
#pragma unroll
        for (int j4 = 0; j4 < 4; ++j4) {
          const float4 wv = *(const float4*)(WG + r * 128 + w * 16 + j4 * 4);
          z2[2 * j4] = g2 * (f32x2_t){wv.x, wv.y} + z2[2 * j4];
          z2[2 * j4 + 1] = g2 * (f32x2_t){wv.z, wv.w} + z2[2 * j4 + 1];
        }
      }
      float la[16], x[16];
#pragma unroll
      for (int j = 0; j < 16; ++j) {
        const float z = (j & 1) ? z2[j >> 1][1] : z2[j >> 1][0];
        const float t = __builtin_amdgcn_exp2f(-fabsf(z) * LOG2E);
        la[j] = (fminf(z, 0.f) - __builtin_amdgcn_logf(1.0f + t) * 0.6931471805599453f) * (1.0f / 16.0f);
        x[j] = la[j];
      }
#pragma unroll
      for (int j = 0; j < 16; ++j) x[j] += dpp_move<0x111, 0xF, true>(x[j]);
#pragma unroll
      for (int j = 0; j < 16; ++j) x[j] += dpp_move<0x112, 0xF, true>(x[j]);
#pragma unroll
      for (int j = 0; j < 16; ++j) x[j] += dpp_move<0x114, 0xF, true>(x[j]);
#pragma unroll
      for (int j = 0; j < 16; ++j) x[j] += dpp_move<0x118, 0xF, true>(x[j]);
#pragma unroll
      for (int j = 0; j < 16; ++j) x[j] += dpp_move<0x142, 0xA, false>(x[j]);
#pragma unroll
      for (int j = 0; j < 16; ++j) x[j] += dpp_move<0x143, 0xC, false>(x[j]);
      float qd[16], ki[16], et[16];
#pragma unroll
      for (int j = 0; j < 16; ++j) {
        const float tot = __builtin_bit_cast(float, __builtin_amdgcn_readlane(__builtin_bit_cast(int, x[j]), 63));
        const float cum = dir ? (tot - x[j] + la[j]) : x[j];
        const float e = __builtin_amdgcn_exp2f(cum * LOG2E);
        const float ie = __builtin_amdgcn_rcpf(e);
        const float etv = __builtin_amdgcn_exp2f(tot * LOG2E);
        et[j] = etv;
        const unsigned qw = (j < 8) ? rq0[(j & 7) >> 1] : rq1[(j & 7) >> 1];
        const unsigned kw = (j < 8) ? rk0[(j & 7) >> 1] : rk1[(j & 7) >> 1];
        const float qv = (j & 1) ? bfhi(qw) : bflo(qw);
        const float kv = (j & 1) ? bfhi(kw) : bflo(kw);
        qd[j] = qv * e; ki[j] = kv * ie;
        *(bf16_t*)(KET + ((w * 16 + j) * 72 + lane) * 2) = f2bf(kv * etv * ie);
      }
#pragma unroll
      for (int i = 0; i < 2; ++i) {
        u32x4 a, b;
#pragma unroll
        for (int j = 0; j < 4; ++j) { a[j] = pk2(qd[8 * i + 2 * j], qd[8 * i + 2 * j + 1]); b[j] = pk2(ki[8 * i + 2 * j], ki[8 * i + 2 * j + 1]); }
        *(u32x4*)(QD + (lane * 136 + w * 16 + 8 * i) * 2) = a;
        *(u32x4*)(KI + (lane * 136 + w * 16 + 8 * i) * 2) = b;
      }
      if (lane == 0) {
#pragma unroll
        for (int j4 = 0; j4 < 4; ++j4) *(f32x4*)(ETOT + w * 16 + j4 * 4) = (f32x4){et[4 * j4], et[4 * j4 + 1], et[4 * j4 + 2], et[4 * j4 + 3]};
      }
      *(u32x4*)(VTs + (vv_ * 72 + vch_ * 8) * 2) = rvv;
    }
    LDS_BARRIER();
    if (step + 1 < 36) { const int un = dir ? (34 - step) : (step + 1 < 4 ? 33 + step : step - 3); GLA_LOAD(un); }
    {
      const int ct = w & 3, vh = w >> 2;
      bf16x8 qdf[4];
#pragma unroll
      for (int ks = 0; ks < 4; ++ks) qdf[ks] = *(const bf16x8*)(QD + ((ct * 16 + l15) * 136 + ks * 32 + quad * 8) * 2);
      f32x4 sc[4];
#pragma unroll
      for (int nt = 0; nt < 4; ++nt) {
        sc[nt] = (f32x4){0.f, 0.f, 0.f, 0.f};
#pragma unroll
        for (int ks = 0; ks < 4; ++ks) {
          const bf16x8 kf = *(const bf16x8*)(KI + ((nt * 16 + l15) * 136 + ks * 32 + quad * 8) * 2);
          sc[nt] = MFMA16(kf, qdf[ks], sc[nt]);
        }
        const int cidx = ct * 16 + l15;
#pragma unroll
        for (int i = 0; i < 4; ++i) {
          const int sidx = nt * 16 + quad * 4 + i;
          const bool keep = dir ? (sidx > cidx) : (sidx <= cidx);
          if (!keep) sc[nt][i] = 0.f;
        }
      }
      bf16x8 pb[2];
#pragma unroll
      for (int k2 = 0; k2 < 2; ++k2) {
        u32x4 pw;
        pw[0] = pk2(sc[2 * k2][0], sc[2 * k2][1]); pw[1] = pk2(sc[2 * k2][2], sc[2 * k2][3]);
        pw[2] = pk2(sc[2 * k2 + 1][0], sc[2 * k2 + 1][1]); pw[3] = pk2(sc[2 * k2 + 1][2], sc[2 * k2 + 1][3]);
        pb[k2] = __builtin_bit_cast(bf16x8, pw);
      }
#pragma unroll
      for (int nv = 0; nv < 2; ++nv) {
        const int vrow = vh * 32 + nv * 16 + l15;
        f32x4 oo = (f32x4){0.f, 0.f, 0.f, 0.f};
#pragma unroll
        for (int k2 = 0; k2 < 2; ++k2) {
          const s16x4 lo = *(const s16x4*)(VTs + (vrow * 72 + k2 * 32 + quad * 4) * 2);
          const s16x4 hi = *(const s16x4*)(VTs + (vrow * 72 + k2 * 32 + 16 + quad * 4) * 2);
          const bf16x8 vf = __builtin_shufflevector(lo, hi, 0, 1, 2, 3, 4, 5, 6, 7);
          oo = MFMA16(vf, pb[k2], oo);
        }
#pragma unroll
        for (int ks = 0; ks < 4; ++ks) {
          const bf16x8 sf = *(const bf16x8*)(STs + (vrow * 136 + ks * 32 + quad * 8) * 2);
          oo = MFMA16(sf, qdf[ks], oo);
        }
        *(u32x2*)(OUT + (size_t)(row0 + ct * 16 + l15) * 1024 + h * 256 + sl * 64 + vh * 32 + nv * 16 + quad * 4) = pk4(oo);
      }
    }
    LDS_BARRIER();
    {
      const f32x4 dec = *(const f32x4*)(ETOT + w * 16 + quad * 4);
#pragma unroll
      for (int vt = 0; vt < 4; ++vt) S[vt] *= dec;
#pragma unroll
      for (int k2 = 0; k2 < 2; ++k2) {
        const bf16x8 kef = *(const bf16x8*)(KET + ((w * 16 + l15) * 72 + k2 * 32 + quad * 8) * 2);
#pragma unroll
        for (int vt = 0; vt < 4; ++vt) {
          const bf16x8 vf = *(const bf16x8*)(VTs + ((vt * 16 + l15) * 72 + k2 * 32 + quad * 8) * 2);
          S[vt] = MFMA16(kef, vf, S[vt]);
        }
      }
#pragma unroll
      for (int vt = 0; vt < 4; ++vt) *(u32x2*)(STs + ((vt * 16 + l15) * 136 + w * 16 + quad * 4) * 2) = pk4(S[vt]);
    }
  }
#undef GLA_LOAD
  __syncthreads();
}

DI void mixers_phase(const Params& p, int l, int g, bool last, unsigned char* lds) {
  unsigned char* act = p.ws + OFF_ACT;
  const int xcd = blockIdx.x & 7;
  unsigned* ctr = (unsigned*)(p.ws + OFF_CTR) + ((l * NGRP + g) * 8 + xcd);
  int* s_item = (int*)(lds + L_ITEM);
  const int n_gla = BG * 4 * 4 * 2, n_mla = BG * 8 * 8, n_swa = BG * 4 * 16, n_mlac = last ? 0 : BG * 8, n_swac = last ? 0 : BG * 16 * 2;
  const int total = n_gla + n_mla + n_swa + n_mlac + n_swac;
  for (;;) {
    if (opaque_tid() == 0) *s_item = (int)atomicAdd(ctr, 1u);
    __syncthreads();
    int it = *s_item;
    __syncthreads();
    if (it >= total / 8) break;
    if (it < n_gla / 8) {
      it += xcd * (n_gla / 8);
      const int dir = it & 1, sl = (it >> 1) & 3, h = (it >> 3) & 3, bl = it >> 5;
      gla_chain(p, l, bl, h, sl, dir, lds);
      continue;
    }
    it -= n_gla / 8;
    if (it < n_mla / 8) {
      it += xcd * (n_mla / 8);
      const int bl = it >> 6, h = (it >> 3) & 7, qb = it & 7;
      bf16_t* QF = (bf16_t*)(act + A_QF) + h * 192;
      attn_item<6, 8, 2, true>(QF, 1536, QF, 1536, (const bf16_t*)(act + A_KN) + h * 128, 1024, (const bf16_t*)(act + A_KR),
                               (const bf16_t*)(act + A_VT) + ((size_t)bl * 1024 + h * 128) * TT, bl * TT + qb * 256, qb * 256, bl * TT, 0, 36, 0, 0,
                               false, false, nullptr, lds);
      continue;
    }
    it -= n_mla / 8;
    if (it < n_swa / 8) {
      it += xcd * (n_swa / 8);
      const int bl = it >> 6, gk = (it >> 5) & 1, hh = (it >> 4) & 1, qi = it & 15, hq0 = gk * 8 + hh * 4;
      bf16_t* SQ = (bf16_t*)(act + A_SQ) + hq0 * 64;
      const int a0 = (2 * qi - 2) < 0 ? 0 : (2 * qi - 2), a1 = (2 * qi + 4) > 32 ? 32 : (2 * qi + 4);
      attn_item<2, 4, 4, false, true>(SQ, 1024, SQ, 1024, (const bf16_t*)(act + A_SK) + gk * 64, 128, nullptr,
                                      (const bf16_t*)(act + A_SVT) + ((size_t)bl * 128 + gk * 64) * TT, bl * TT + qi * 128, qi * 128, bl * TT, a0, a1, 32, 36,
                                      true, true, p.sinks + l * 16 + hq0, lds);
      continue;
    }
    it -= n_swa / 8;
    if (it < n_mlac / 8) {
      it += xcd * (n_mlac / 8);
      const int bl = it >> 3, h = it & 7;
      bf16_t* QF = (bf16_t*)(act + A_QF) + h * 192;
      attn_item<6, 8, 2, true>(QF, 1536, QF, 1536, (const bf16_t*)(act + A_KN) + h * 128, 1024, (const bf16_t*)(act + A_KR),
                               (const bf16_t*)(act + A_VT) + ((size_t)bl * 1024 + h * 128) * TT, bl * TT + 2048, 2048, bl * TT, 32, 36, 0, 0,
                               false, false, nullptr, lds);
      continue;
    }
    it -= n_mlac / 8;
    {
      it += xcd * (n_swac / 8);
      const int bl = it >> 5, hq = (it >> 1) & 15, half = it & 1, gk = hq >> 3;
      bf16_t* SQ = (bf16_t*)(act + A_SQ) + hq * 64;
      attn_item<2, 4, 1, false>(SQ, 1024, SQ, 1024, (const bf16_t*)(act + A_SK) + gk * 64, 128, nullptr,
                                (const bf16_t*)(act + A_SVT) + ((size_t)bl * 128 + gk * 64) * TT, bl * TT + 2048 + half * 128, 2048 + half * 128, bl * TT,
                                32, 36, 0, 0, false, true, p.sinks + l * 16 + hq, lds);
    }
  }
}

DI void glapost_phase(const Params& p, int l) {
  unsigned char* act = p.ws + OFF_ACT;
  const bf16_t* OF = (const bf16_t*)(act + A_H);
  const bf16_t* OB = (const bf16_t*)(act + A_OB);
  bf16_t* GG = (bf16_t*)(act + A_GG);
  const float* gn = p.gla_norm + l * 256;
  const int tid = opaque_tid(), lane = tid & 63, w = tid >> 6;
  for (int r = blockIdx.x * 8 + w; r < R; r += gridDim.x * 8) {
    const size_t off = (size_t)r * 1024 + lane * 16;
    float v[16];
    float ss = 0.f;
#pragma unroll
    for (int c = 0; c < 2; ++c) {
      const u32x4 a = *(const u32x4*)(OF + off + c * 8), b = *(const u32x4*)(OB + off + c * 8);
#pragma unroll
      for (int j = 0; j < 4; ++j) { v[c * 8 + 2 * j] = bflo(a[j]) + bflo(b[j]); v[c * 8 + 2 * j + 1] = bfhi(a[j]) + bfhi(b[j]); }
    }
#pragma unroll
    for (int j = 0; j < 16; ++j) ss += v[j] * v[j];
#pragma unroll
    for (int o = 8; o >= 1; o >>= 1) ss += shx(ss, lane, o);
    const float rstd = rsqrtf(ss * (1.0f / 256.0f) + 1e-6f);
    const int vcol = (lane & 15) * 16;
#pragma unroll
    for (int c = 0; c < 2; ++c) {
      const u32x4 gq = *(const u32x4*)(GG + off + c * 8);
      u32x4 o;
#pragma unroll
      for (int j = 0; j < 4; ++j) {
        const float g0 = bflo(gq[j]), g1 = bfhi(gq[j]);
        const float y0 = v[c * 8 + 2 * j] * rstd * gn[vcol + c * 8 + 2 * j] * siluf_(g0);
        const float y1 = v[c * 8 + 2 * j + 1] * rstd * gn[vcol + c * 8 + 2 * j + 1] * siluf_(g1);
        o[j] = pk2(y0, y1);
      }
      *(u32x4*)(GG + off + c * 8) = o;
    }
  }
}

#define MERGE_SCALE_T(ACC, NTT, BR, COL0) do { \
      const int tid = opaque_tid(), lane = tid & 63, w = tid >> 6, wm = w >> 1, wn = w & 1, l15 = lane & 15, quad = lane >> 4; \
      const bf16_t* mg = (const bf16_t*)(act + A_MG) + (size_t)r0 * 3072 + (BR) * 1024 + (COL0) + wn * (NTT) * 16; \
      _Pragma("unroll") for (int mt = 0; mt < 4; ++mt) _Pragma("unroll") for (int nt = 0; nt < (NTT); ++nt) { \
          const bf16_t* gp = mg + (size_t)(wm * 64 + mt * 16 + l15) * 3072 + nt * 16 + quad * 4; \
          const u32x2 gw = *(const u32x2*)(gp); \
          f32x4 f = (f32x4){bflo(gw.x), bfhi(gw.x), bflo(gw.y), bfhi(gw.y)}; \
          if ((BR) < 2) { const u32x2 gn = *(const u32x2*)(gp + 1024); \
            f[0] *= __builtin_amdgcn_rcpf(bflo(gn.x)); f[1] *= __builtin_amdgcn_rcpf(bfhi(gn.x)); \
            f[2] *= __builtin_amdgcn_rcpf(bflo(gn.y)); f[3] *= __builtin_amdgcn_rcpf(bfhi(gn.y)); } \
          ACC[mt][nt] *= f; } } while (0)
DI void merge_phase(const Params& p, bool last, unsigned char* lds) {
  unsigned char* act = p.ws + OFF_ACT;
  for (int i_ = 0;; ++i_) {
    int rt, tn;
    if (!unit_order(i_, BG * 8, 8, rt, tn)) break;
    const int tm = (rt / 8) * 9 + (rt & 7);
    const int r0 = tm * 256;
    f32x4 acc[4][4]; zero_acc(acc);
    gemm_tile<true, false>((const bf16_t*)(act + A_GG) + (size_t)r0 * 1024, 1024, (const bf16_t*)(p.ws + OFF_WM + WM_WPA) + (size_t)tn * 128 * 1024, 1024, 1024, lds, acc);
    MERGE_SCALE_T(acc, 4, 0, tn * 128);
    gemm_tile<true, false>((const bf16_t*)(act + A_SQ) + (size_t)r0 * 1024, 1024, (const bf16_t*)(p.ws + OFF_WM + WM_WPB) + (size_t)tn * 128 * 1024, 1024, 1024, lds, acc);
    MERGE_SCALE_T(acc, 4, 1, tn * 128);
    gemm_tile<true, true>((const bf16_t*)(act + A_QF) + (size_t)r0 * 1536, 1536, (const bf16_t*)(p.ws + OFF_WM + WM_WPC) + (size_t)tn * 128 * 1024, 1024, 1024, lds, acc);
    MERGE_SCALE_T(acc, 4, 2, tn * 128);
    stage_rows<4>(acc, lds, (bf16_t*)(act + A_GQK) + (size_t)r0 * 1024 + tn * 128, 1024, 1.0f);
  }
  if (last) return;
  for (int id = blockIdx.x; id < BG * 16; id += gridDim.x) {
    const int tm = (id >> 4) * 9 + 8, t64 = id & 15;
    const int r0 = tm * 256;
    f32x4 acc[4][2];
#pragma unroll
    for (int a_ = 0; a_ < 4; ++a_) { acc[a_][0] = (f32x4){0.f, 0.f, 0.f, 0.f}; acc[a_][1] = (f32x4){0.f, 0.f, 0.f, 0.f}; }
    gemm_tile_n64<false>((const bf16_t*)(act + A_GG) + (size_t)r0 * 1024, 1024, (const bf16_t*)(p.ws + OFF_WM + WM_WPA) + (size_t)t64 * 64 * 1024, 1024, 1024, lds, acc);
    MERGE_SCALE_T(acc, 2, 0, t64 * 64);
    gemm_tile_n64<false>((const bf16_t*)(act + A_SQ) + (size_t)r0 * 1024, 1024, (const bf16_t*)(p.ws + OFF_WM + WM_WPB) + (size_t)t64 * 64 * 1024, 1024, 1024, lds, acc);
    MERGE_SCALE_T(acc, 2, 1, t64 * 64);
    gemm_tile_n64<true>((const bf16_t*)(act + A_QF) + (size_t)r0 * 1536, 1536, (const bf16_t*)(p.ws + OFF_WM + WM_WPC) + (size_t)t64 * 64 * 1024, 1024, 1024, lds, acc);
    MERGE_SCALE_T(acc, 2, 2, t64 * 64);
    stage_rows<2>(acc, lds, (bf16_t*)(act + A_GQK) + (size_t)r0 * 1024 + t64 * 64, 1024, 1.0f);
  }
}
#undef MERGE_SCALE_T

DI void resid_epilogue(const f32x4 (&acc)[4][4], const float* srcp, float* dstp, const float* gate, int wm, int l15, int quad) {
#pragma unroll
  for (int mt = 0; mt < 4; ++mt) {
    const size_t ro = (size_t)(wm * 64 + mt * 16 + l15) * 1024 + quad * 4;
#pragma unroll
    for (int nt = 0; nt < 4; ++nt) {
      const f32x4 xo = *(const f32x4*)(srcp + ro + nt * 16);
      const f32x4 gv = *(const f32x4*)(gate + nt * 16 + quad * 4);
      *(f32x4*)(dstp + ro + nt * 16) = xo + gv * acc[mt][nt];
    }
  }
}

DI void resid_epilogue2(const f32x4 (&acc)[4][2], const float* srcp, float* dstp, const float* gate, int wm, int l15, int quad) {
#pragma unroll
  for (int mt = 0; mt < 4; ++mt) {
    const size_t ro = (size_t)(wm * 64 + mt * 16 + l15) * 1024 + quad * 4;
#pragma unroll
    for (int nt = 0; nt < 2; ++nt) {
      const f32x4 xo = *(const f32x4*)(srcp + ro + nt * 16);
      const f32x4 gv = *(const f32x4*)(gate + nt * 16 + quad * 4);
      *(f32x4*)(dstp + ro + nt * 16) = xo + gv * acc[mt][nt];
    }
  }
}
DI void wo_phase(const Params& p, int l, int g, bool last, unsigned char* lds) {
  unsigned char* act = p.ws + OFF_ACT;
  const float* MOD = (const float*)(p.ws + OFF_MOD);
  float* XC = (float*)(p.ws + OFF_XC);
  for (int i_ = 0;; ++i_) {
    int rt, tn;
    if (!unit_order(i_, BG * 8, 8, rt, tn)) break;
    const int bl = rt >> 3, tt = rt & 7, tm = bl * 9 + tt, b = g * BG + bl;
    const int r0 = tm * 256;
    f32x4 acc[4][4]; zero_acc(acc);
    gemm_tile<true, false>((const bf16_t*)(act + A_GQK) + (size_t)r0 * 1024, 1024, (const bf16_t*)(p.ws + OFF_WM + WM_WO) + (size_t)tn * 128 * 1024, 1024, 1024, lds, acc);
    const int tid = opaque_tid(), lane = tid & 63, w = tid >> 6, wm = w >> 1, wn = w & 1, l15 = lane & 15, quad = lane >> 4;
    const int coff = tn * 128 + wn * 64;
    const size_t base = ((size_t)b * 2048 + tt * 256) * 1024 + coff;
    resid_epilogue(acc, (l == 0 ? p.x : p.out) + base, p.out + base, MOD + (size_t)(l * 9 + b) * 6144 + 2048 + coff, wm, l15, quad);
  }
  if (last) return;
  for (int id = blockIdx.x; id < BG * 16; id += gridDim.x) {
    const int bl = id >> 4, t64 = id & 15, tm = bl * 9 + 8, b = g * BG + bl;
    const int r0 = tm * 256;
    f32x4 acc[4][2];
#pragma unroll
    for (int a_ = 0; a_ < 4; ++a_) { acc[a_][0] = (f32x4){0.f, 0.f, 0.f, 0.f}; acc[a_][1] = (f32x4){0.f, 0.f, 0.f, 0.f}; }
    gemm_tile_n64<false>((const bf16_t*)(act + A_GQK) + (size_t)r0 * 1024, 1024, (const bf16_t*)(p.ws + OFF_WM + WM_WO) + (size_t)t64 * 64 * 1024, 1024, 1024, lds, acc);
    const int tid = opaque_tid(), lane = tid & 63, w = tid >> 6, wm = w >> 1, wn = w & 1, l15 = lane & 15, quad = lane >> 4;
    const int coff = t64 * 64 + wn * 32;
    const size_t base = ((size_t)b * 256) * 1024 + coff;
    resid_epilogue2(acc, (l == 0 ? p.ctx : XC) + base, XC + base, MOD + (size_t)(l * 9 + 8) * 6144 + 2048 + coff, wm, l15, quad);
  }
}

DI void ffnin_epi(const Params& p, const f32x4 (&acc)[4][4], int r0, int tn, unsigned char* lds) {
  unsigned char* act = p.ws + OFF_ACT;
  f32x4 hv[4][2];
#pragma unroll
  for (int mt = 0; mt < 4; ++mt)
#pragma unroll
    for (int np = 0; np < 2; ++np) {
      const f32x4 gte = acc[mt][2 * np], up = acc[mt][2 * np + 1];
#pragma unroll
      for (int i = 0; i < 4; ++i) hv[mt][np][i] = siluf_(gte[i]) * up[i];
    }
  stage_rows<2>(hv, lds, (bf16_t*)(act + F_HID) + (size_t)r0 * 2816 + tn * 64, 2816, 1.0f);
}
DI void ffnin_phase(const Params& p, bool last, unsigned char* lds) {
  unsigned char* act = p.ws + OFF_ACT;
  const int nrt = last ? 64 : 72;
  const int total = nrt * 22, G_ = gridDim.x;
  const int full = (total / G_) * G_;
  for (int i_ = 0; i_ * G_ < full; ++i_) {
    int rt, tp;
    if (!unit_order(i_, nrt, 22, rt, tp)) break;
    const int tm = last ? (rt / 8) * 9 + (rt & 7) : rt;
    const int r0 = tm * 256;
    f32x4 acc0[4][4], acc1[4][4]; zero_acc(acc0); zero_acc(acc1);
    gemm_tile2<true>((const bf16_t*)(act + F_H2) + (size_t)r0 * 1024, 1024, (const bf16_t*)(act + F_WFI) + (size_t)tp * 256 * 1024, 1024, 1024, lds, acc0, acc1);
    ffnin_epi(p, acc0, r0, 2 * tp, lds);
    ffnin_epi(p, acc1, r0, 2 * tp + 1, lds);
  }
  for (int sidx = blockIdx.x; sidx < 2 * (total - full); sidx += G_) {
    int rt, tp;
    if (!unit_of((long)full + (sidx >> 1), nrt, 22, rt, tp)) break;
    const int tm = last ? (rt / 8) * 9 + (rt & 7) : rt;
    const int r0 = tm * 256, tn = 2 * tp + (sidx & 1);
    f32x4 acc[4][4]; zero_acc(acc);
    gemm_tile<true, false>((const bf16_t*)(act + F_H2) + (size_t)r0 * 1024, 1024, (const bf16_t*)(act + F_WFI) + (size_t)tn * 128 * 1024, 1024, 1024, lds, acc);
    ffnin_epi(p, acc, r0, tn, lds);
  }
}

DI void ffnout_epi(const Params& p, const f32x4 (&acc)[4][4], int l, int tm, int tn) {
  const float* MOD = (const float*)(p.ws + OFF_MOD);
  float* XC = (float*)(p.ws + OFF_XC);
  const int tid = opaque_tid(), lane = tid & 63, w = tid >> 6, wm = w >> 1, wn = w & 1, l15 = lane & 15, quad = lane >> 4;
  const int b = tm / 9, tt = tm - b * 9;
  const int coff = tn * 128 + wn * 64;
  if (tt < 8) {
    const size_t base = ((size_t)b * 2048 + tt * 256) * 1024 + coff;
    resid_epilogue(acc, p.out + base, p.out + base, MOD + (size_t)(l * 9 + b) * 6144 + 5120 + coff, wm, l15, quad);
  } else {
    const size_t base = ((size_t)b * 256) * 1024 + coff;
    resid_epilogue(acc, XC + base, XC + base, MOD + (size_t)(l * 9 + 8) * 6144 + 5120 + coff, wm, l15, quad);
  }
}
DI void ffnout_phase(const Params& p, int l, bool last, unsigned char* lds) {
  unsigned char* act = p.ws + OFF_ACT;
  const int nrt = last ? 64 : 72;
  for (int i_ = 0;; ++i_) {
    int rt, tp;
    if (!unit_order(i_, nrt, 4, rt, tp)) break;
    const int tm = last ? (rt / 8) * 9 + (rt & 7) : rt;
    const int r0 = tm * 256;
    f32x4 acc0[4][4], acc1[4][4]; zero_acc(acc0); zero_acc(acc1);
    gemm_tile2<true>((const bf16_t*)(act + F_HID) + (size_t)r0 * 2816, 2816, (const bf16_t*)(act + F_WFO) + (size_t)tp * 256 * 2816, 2816, 2816, lds, acc0, acc1);
    ffnout_epi(p, acc0, l, tm, 2 * tp);
    ffnout_epi(p, acc1, l, tm, 2 * tp + 1);
  }
}

DI void convert_mixer_weights(const Params& p, int l, unsigned char* lds) {
  unsigned char* wm = p.ws + OFF_WM;
  const int tid = opaque_tid(), lane = tid & 63, w = tid >> 6;
  float* wl = (float*)(lds + w * 4352);
  const int total = 13344;
  for (int id = blockIdx.x * 8 + w; id < total; id += gridDim.x * 8) {
    const float* src; int K, N, mode = 0, rem; bf16_t* dst; const float* ks = nullptr;
    if (id < 8160) { src = p.w_in + (size_t)l * 1024 * 8160; K = 1024; N = 8160; dst = (bf16_t*)(wm + WM_WIN); mode = 1; rem = id; }
    else if (id < 8736) { src = p.w_q_up + (size_t)l * 384 * 1536; K = 384; N = 1536; dst = (bf16_t*)(wm + WM_WQU); ks = p.q_norm + l * 384; rem = id - 8160; }
    else if (id < 9248) { src = p.w_kv_up + (size_t)l * 256 * 2048; K = 256; N = 2048; dst = (bf16_t*)(wm + WM_WKVU); ks = p.kv_norm + l * 256; mode = 3; rem = id - 8736; }
    else if (id < 10272) { src = p.w_pa + (size_t)l * 1024 * 1024; K = 1024; N = 1024; dst = (bf16_t*)(wm + WM_WPA); rem = id - 9248; }
    else if (id < 11296) { src = p.w_pb + (size_t)l * 1024 * 1024; K = 1024; N = 1024; dst = (bf16_t*)(wm + WM_WPB); rem = id - 10272; }
    else if (id < 12320) { src = p.w_pc + (size_t)l * 1024 * 1024; K = 1024; N = 1024; dst = (bf16_t*)(wm + WM_WPC); rem = id - 11296; }
    else { src = p.w_o + (size_t)l * 1024 * 1024; K = 1024; N = 1024; dst = (bf16_t*)(wm + WM_WO); rem = id - 12320; }
    convert_wave_tile(src, K, N, dst, mode, ks, rem, wl, lane);
  }
  if (blockIdx.x == 0) { unsigned* z = (unsigned*)(wm + WM_WIN + (size_t)5088 * 1024 * 2); for (int i = tid; i < 32 * 1024 / 2; i += 512) z[i] = 0u; }
  __syncthreads();
}
DI void convert_ffn_weights(const Params& p, int l, unsigned char* lds) {
  unsigned char* act = p.ws + OFF_ACT;
  const int tid = opaque_tid(), lane = tid & 63, w = tid >> 6;
  float* wl = (float*)(lds + w * 4352);
  const int n1 = 16 * 352, total = n1 + 44 * 64;
  for (int id = blockIdx.x * 8 + w; id < total; id += gridDim.x * 8) {
    if (id < n1) convert_wave_tile(p.w_ffn_in + (size_t)l * 1024 * 5632, 1024, 5632, (bf16_t*)(act + F_WFI), 2, nullptr, id, wl, lane);
    else convert_wave_tile(p.w_ffn_out + (size_t)l * 2816 * 1024, 2816, 1024, (bf16_t*)(act + F_WFO), 0, nullptr, id - n1, wl, lane);
  }
  __syncthreads();
}


#define XB_TMO      128
#define XB_XCNT(j)  (256  + 64 * (j))
#define XB_XSUB(j)  (1280 + 64 * (j))
#define XB_XGEN(j)  (2304 + 64 * (j))
#define XB_TOP      3328
#define XB_TOPGEN   3392
#define XCD_BAR_WORDS 3456
#define XB_SPIN_CAP (1u << 18)
DI unsigned xb_ld(unsigned* p)              { return __hip_atomic_load(p, __ATOMIC_RELAXED, __HIP_MEMORY_SCOPE_AGENT); }
DI unsigned xb_add(unsigned* p, unsigned v) { return __hip_atomic_fetch_add(p, v, __ATOMIC_RELAXED, __HIP_MEMORY_SCOPE_AGENT); }
DI unsigned xb_xcc_id() { return (unsigned)__builtin_amdgcn_s_getreg((3 << 11) | 20) & 0xFu; }
#define XB_SPIN(cond, bar) do { unsigned _sp = 0; while (cond) { __builtin_amdgcn_s_sleep(1); \
    if ((++_sp & 255u) == 0u) { if (xb_ld(&(bar)[XB_TMO])) break; if (_sp > XB_SPIN_CAP) { atomicAdd(&(bar)[XB_TMO], 1u); break; } } } } while (0)
struct XcdBarrier { unsigned* bar; unsigned x; volatile LAS unsigned* st; };
DI XcdBarrier xcd_barrier_post(unsigned* bar, volatile LAS unsigned* st) {
  XcdBarrier b; b.bar = bar; b.x = xb_xcc_id(); b.st = st;
  if (threadIdx.x == 0) (void)xb_add(&bar[XB_XCNT(b.x)], 1u);
  return b;
}
DI void xcd_barrier_complete(unsigned* bar, unsigned x, unsigned& nloc, unsigned& nx) {
  const unsigned G = gridDim.x * gridDim.y * gridDim.z;
  unsigned sum, cnt, mine, sp = 0u;
  for (;;) {
    sum = 0u; cnt = 0u; mine = 0u;
#pragma unroll
    for (unsigned j = 0; j < 16; ++j) { const unsigned c = xb_ld(&bar[XB_XCNT(j)]); sum += c; cnt += (c > 0u) ? 1u : 0u; mine = (j == x) ? c : mine; }
    if (sum == G) break;
    __builtin_amdgcn_s_sleep(1);
    if ((++sp & 255u) == 0u) { if (xb_ld(&bar[XB_TMO])) break; if (sp > XB_SPIN_CAP) { atomicAdd(&bar[XB_TMO], 1u); break; } }
  }
  nloc = mine > 0u ? mine : 1u; nx = cnt > 0u ? cnt : 1u;
}
DI void xcd_barrier(const XcdBarrier& b) {
  asm volatile("s_waitcnt vmcnt(0)" ::: "memory");
  __syncthreads();
  if (threadIdx.x == 0) {
    unsigned* bar = b.bar;
    __builtin_amdgcn_s_waitcnt(0);
    unsigned nloc = b.st[0], nx = b.st[1];
    if (nloc == 0u) { xcd_barrier_complete(bar, b.x, nloc, nx); b.st[0] = nloc; b.st[1] = nx; }
    const unsigned old = xb_add(&bar[XB_XSUB(b.x)], 1u);
    const unsigned gen = old / nloc;
    if (old + 1u == (gen + 1u) * nloc) {
      __builtin_amdgcn_fence(__ATOMIC_RELEASE, "agent");
      asm volatile("s_waitcnt vmcnt(0)" ::: "memory");
      const unsigned og = xb_add(&bar[XB_TOP], 1u);
      const unsigned tg = og / nx;
      if (og + 1u == (tg + 1u) * nx) xb_add(&bar[XB_TOPGEN], 1u);
      else XB_SPIN(xb_ld(&bar[XB_TOPGEN]) == tg, bar);
      __builtin_amdgcn_fence(__ATOMIC_ACQUIRE, "agent");
      xb_add(&bar[XB_XGEN(b.x)], 1u);
      asm volatile("s_waitcnt vmcnt(0)" ::: "memory");
    } else {
      XB_SPIN(xb_ld(&bar[XB_XGEN(b.x)]) == gen, bar);
      __builtin_amdgcn_fence(__ATOMIC_ACQUIRE, "agent");
      asm volatile("s_waitcnt vmcnt(0)" ::: "memory");
    }
  }
  __syncthreads();
}

DI void grid_barrier(unsigned* ctr, unsigned& phase) {
  asm volatile("s_waitcnt vmcnt(0)" ::: "memory");
  __syncthreads();
  phase += 1u;
  if (threadIdx.x == 0) {
    __builtin_amdgcn_fence(__ATOMIC_RELEASE, "agent");
    asm volatile("s_waitcnt vmcnt(0)" ::: "memory");
    __hip_atomic_fetch_add(ctr, 1u, __ATOMIC_RELAXED, __HIP_MEMORY_SCOPE_AGENT);
    const unsigned target = phase * gridDim.x;
    unsigned spins = 0;
    while (__hip_atomic_load(ctr, __ATOMIC_RELAXED, __HIP_MEMORY_SCOPE_AGENT) < target) { __builtin_amdgcn_s_sleep(1); if (++spins > (1u << 24)) break; }
    __builtin_amdgcn_fence(__ATOMIC_ACQUIRE, "agent");
    asm volatile("s_waitcnt vmcnt(0)" ::: "memory");
  }
  __syncthreads();
}

__global__ void __launch_bounds__(512) fwd_megakernel(Params p) {
  cg::grid_group grid = cg::this_grid();
  unsigned char* lds = dyn_lds;
  unsigned char* act = p.ws + OFF_ACT;
  unsigned* gbar = (unsigned*)(p.ws + OFF_CTR) + 128;
  unsigned bphase = 0u;
  if (blockIdx.x == 0) { const int t0 = opaque_tid(); if (t0 < 256) ((unsigned*)(p.ws + OFF_CTR))[t0] = 0u;
    for (int i = t0; i < XCD_BAR_WORDS; i += 512) ((unsigned*)(p.ws + OFF_XBAR))[i] = 0u; }
  volatile LAS unsigned* xb_st = (volatile LAS unsigned*)((LAS unsigned char*)dyn_lds + (LDS_BYTES - 32));
  if (threadIdx.x == 0) { xb_st[0] = 0u; xb_st[1] = 0u; }
  grid.sync();
  const XcdBarrier xbar = xcd_barrier_post((unsigned*)(p.ws + OFF_XBAR), xb_st);
  {
    const int tid = opaque_tid(), lane = tid & 63, w = tid >> 6;
    float* sc = (float*)lds;
    float* red = (float*)(lds + 36864);
    float* MOD = (float*)(p.ws + OFF_MOD);
    for (int item = blockIdx.x; item < 192; item += gridDim.x) {
      for (int i = tid; i < 9216; i += 512) { const int b = i >> 10, k = i & 1023; const float v = b < 8 ? p.c[b * 1024 + k] : p.c_ctx[k]; sc[i] = siluf_(v); }
      __syncthreads();
      const int l = item / 96, cb = (item % 96) * 64;
      float a[9];
#pragma unroll
      for (int b = 0; b < 9; ++b) a[b] = 0.f;
      const float* wp = p.w_mod + ((size_t)l * 1024 + w * 128) * 6144 + cb + lane;
#pragma unroll 8
      for (int k = 0; k < 128; ++k) {
        const float wv = wp[(size_t)k * 6144];
#pragma unroll
        for (int b = 0; b < 9; ++b) a[b] += sc[b * 1024 + w * 128 + k] * wv;
      }
#pragma unroll
      for (int b = 0; b < 9; ++b) red[(w * 9 + b) * 64 + lane] = a[b];
      __syncthreads();
      for (int i = tid; i < 576; i += 512) {
        const int b = i >> 6, ln = i & 63;
        float s = 0.f;
        for (int ww = 0; ww < 8; ++ww) s += red[(ww * 9 + b) * 64 + ln];
        MOD[(size_t)(l * 9 + b) * 6144 + cb + ln] = s + p.b_mod[l * 6144 + cb + ln];
      }
      __syncthreads();
    }
    if (blockIdx.x == gridDim.x - 1) {
      float2* rope = (float2*)(p.ws + OFF_ROPE);
      for (int i = tid; i < 1024; i += 512) {
        const int pos = i >> 4, f = i & 15;
        const float inv = powf(10000.0f, -(float)f / 16.0f);
        const float ang = (float)pos * inv;
        rope[i] = make_float2(cosf(ang), sinf(ang));
      }
    }
  }
  for (int l_ = 0; l_ < 2; ++l_) {
    int l = l_; asm volatile("" : "+s"(l));
    const bool last = (l == 1);
    convert_mixer_weights(p, l, lds);
    xcd_barrier(xbar);
    for (int g = 0; g < NGRP; ++g) {
      if (g == 0) {
        { float* rsq = (float*)(p.ws + OFF_RSQ); for (int i = blockIdx.x * 512 + opaque_tid(); i < 2 * R; i += gridDim.x * 512) rsq[i] = 0.f; }
        norm_phase(p, l, 0, 0, BG, l == 0 ? p.x : p.out, l == 0 ? p.ctx : (const float*)(p.ws + OFF_XC), (bf16_t*)(act + A_H), false);
        xcd_barrier(xbar);
      }
      inproj_phase(p, g, lds);
      xcd_barrier(xbar);
      mlaup_phase(p, last, lds);
      xcd_barrier(xbar);
      mixers_phase(p, l, g, last, lds);
      xcd_barrier(xbar);
      glapost_phase(p, l);
      xcd_barrier(xbar);
      merge_phase(p, last, lds);
      xcd_barrier(xbar);
      wo_phase(p, l, g, last, lds);
      if (g == NGRP - 1) { __syncthreads(); convert_ffn_weights(p, l, lds); }
      if (g == 0) {
        { float* rsq = (float*)(p.ws + OFF_RSQ); for (int i = blockIdx.x * 512 + opaque_tid(); i < 2 * R; i += gridDim.x * 512) rsq[i] = 0.f; }
        norm_phase(p, l, 0, BG, BG, l == 0 ? p.x : p.out, l == 0 ? p.ctx : (const float*)(p.ws + OFF_XC), (bf16_t*)(act + A_H), false);
      }
      xcd_barrier(xbar);
    }
    {
      norm_phase(p, l, 1, 0, 8, p.out, (const float*)(p.ws + OFF_XC), (bf16_t*)(act + F_H2), last);
    }
    xcd_barrier(xbar);
    ffnin_phase(p, last, lds);
    xcd_barrier(xbar);
    ffnout_phase(p, l, last, lds);
    xcd_barrier(xbar);
  }
  const int tid = opaque_tid(), lane = tid & 63, w = tid >> 6;
  for (int r = blockIdx.x * 8 + w; r < 16384; r += gridDim.x * 8) {
    float* xp = p.out + (size_t)r * 1024;
    float4 v[4]; float ss = 0.f;
#pragma unroll
    for (int i = 0; i < 4; ++i) { v[i] = *(const float4*)(xp + lane * 4 + 256 * i); ss += v[i].x * v[i].x + v[i].y * v[i].y + v[i].z * v[i].z + v[i].w * v[i].w; }
#pragma unroll
    for (int o = 32; o >= 1; o >>= 1) ss += shx(ss, lane, o);
    const float rstd = rsqrtf(ss * (1.0f / 1024.0f) + 1e-6f);
#pragma unroll
    for (int i = 0; i < 4; ++i) {
      const float4 gn = *(const float4*)(p.final_norm + lane * 4 + 256 * i);
      float4 o; o.x = v[i].x * rstd * gn.x; o.y = v[i].y * rstd * gn.y; o.z = v[i].z * rstd * gn.z; o.w = v[i].w * rstd * gn.w;
      *(float4*)(xp + lane * 4 + 256 * i) = o;
    }
  }
}

extern "C" void kernel_launch(void* const* d_in, const int* in_sizes, int n_in, void* d_out, int out_size, void* d_ws, size_t ws_size,
                              hipStream_t stream) {
  constexpr size_t kDynLds = LDS_BYTES;
  static int grid_blocks = 0;
  if (!grid_blocks) {
    int dev = 0, cus = 0, per_cu = 0;
    hipGetDevice(&dev);
    hipDeviceGetAttribute(&cus, hipDeviceAttributeMultiprocessorCount, dev);
    hipFuncSetAttribute((const void*)fwd_megakernel, hipFuncAttributeMaxDynamicSharedMemorySize, (int)kDynLds);
    hipOccupancyMaxActiveBlocksPerMultiprocessor(&per_cu, fwd_megakernel, 512, kDynLds);
    if (per_cu < 1) per_cu = 1;
    if (per_cu > 1) per_cu = 1;
    grid_blocks = cus * per_cu;
  }
  if (ws_size < WS_NEED) { fprintf(stderr, "workspace too small: %zu < %zu\n", ws_size, (size_t)WS_NEED); }
  Params p{};
  const float** pp = (const float**)&p;
  for (int i = 0; i < 26; ++i) pp[i] = (const float*)d_in[i];
  p.out = (float*)d_out;
  p.ws = (unsigned char*)d_ws;
  void* args[] = {&p};
  hipError_t e = hipLaunchCooperativeKernel((void*)fwd_megakernel, dim3(grid_blocks), dim3(512), args, kDynLds, stream);
  if (e != hipSuccess) fprintf(stderr, "cooperative launch failed: %s (grid %d)\n", hipGetErrorString(e), grid_blocks);
}
```
